# Optimizing an MI355X kernel written in HIP

```python
import math
import jax, jax.numpy as jnp
from jax import lax
import numpy as np


D_MODEL = 1024
BATCH = 4
SEQ = 8192
DEPTH = 2

PLE_DIM = 256
N_BRANCH = 3
CONV_DIM = 512
CONV_WIDTH = 3
SB_HEADS = 8
SB_HEAD_DIM = 64
DIFF_HEADS = 4
DIFF_HEAD_DIM = 64
DIFF_V_DIM = 2 * DIFF_HEAD_DIM
ROPE_THETA = 10000.0
Q_BLOCK = 128
EPS = 1e-6
IN_SIZES = (CONV_DIM, CONV_DIM, CONV_DIM, CONV_DIM,
            SB_HEADS * SB_HEAD_DIM, SB_HEADS * SB_HEAD_DIM, SB_HEADS * SB_HEAD_DIM, SB_HEADS * SB_HEAD_DIM,
            DIFF_HEADS * 2 * DIFF_HEAD_DIM, DIFF_HEADS * 2 * DIFF_HEAD_DIM,
            DIFF_HEADS * DIFF_V_DIM, DIFF_HEADS * DIFF_V_DIM,
            N_BRANCH * D_MODEL)
IN_W = sum(IN_SIZES)

kernel_name = 'hybrid_conv_stickbreak_diffattn'


def _rmsnorm(x, w):
    xf = x.astype(jnp.float32)
    y = xf * lax.rsqrt(jnp.mean(xf * xf, axis=-1, keepdims=True) + EPS)
    return (y * w.astype(jnp.float32)).astype(x.dtype)


def _split_points():
    pts, acc = [], 0
    for s in IN_SIZES[:-1]:
        acc += s
        pts.append(acc)
    return pts


def _rope_tables(seq, dim, dtype):
    pos = jnp.arange(seq, dtype=jnp.float32)
    inv = 1.0 / (ROPE_THETA ** (jnp.arange(0, dim, 2, dtype=jnp.float32) / dim))
    ang = pos[:, None] * inv[None, :]
    return jnp.cos(ang).astype(dtype), jnp.sin(ang).astype(dtype)


def _rope(x, cos, sin):
    half = x.shape[-1] // 2
    x1, x2 = x[..., :half], x[..., half:]
    return jnp.concatenate([x1 * cos - x2 * sin, x1 * sin + x2 * cos], axis=-1)


def _causal_conv(v, w):
    width, seq = w.shape[0], v.shape[1]
    vp = jnp.pad(v, ((0, 0), (width - 1, 0), (0, 0)))
    out = w[0] * vp[:, 0:seq]
    for j in range(1, width):
        out = out + w[j] * vp[:, j:j + seq]
    return out


def _to_blocks(q):
    lead, s, d = q.shape[:-2], q.shape[-2], q.shape[-1]
    qb = q.reshape(*lead, s // Q_BLOCK, Q_BLOCK, d)
    return jnp.moveaxis(qb, -3, 0)


def _from_blocks(o):
    o = jnp.moveaxis(o, 0, -3)
    return o.reshape(*o.shape[:-3], o.shape[-3] * o.shape[-2], o.shape[-1])


def _stick_breaking_attention(q, k, v):
    seq = k.shape[-2]
    scale = q.shape[-1] ** -0.5
    kpos = jnp.arange(seq)

    def block(args):
        qi, bi = args
        z = jnp.einsum('bhqd,bhkd->bhqk', qi, k).astype(jnp.float32) * scale
        qpos = bi * Q_BLOCK + jnp.arange(Q_BLOCK)
        past = kpos[None, :] < qpos[:, None]
        log_keep = jnp.where(past, jax.nn.log_sigmoid(-z), 0.0)
        later = lax.cumsum(log_keep, axis=3, reverse=True) - log_keep
        weights = jnp.where(past, jnp.exp(jax.nn.log_sigmoid(z) + later), 0.0)
        return jnp.einsum('bhqk,bhkd->bhqd', weights.astype(v.dtype), v)

    out = lax.map(block, (_to_blocks(q), jnp.arange(seq // Q_BLOCK)))
    return _from_blocks(out)


def _diff_attention(q, k, v, lam):
    seq = k.shape[-2]
    scale = q.shape[-1] ** -0.5
    kpos = jnp.arange(seq)

    def block(args):
        qi, bi = args
        s = jnp.einsum('bhcqd,bhckd->bhcqk', qi, k).astype(jnp.float32) * scale
        qpos = bi * Q_BLOCK + jnp.arange(Q_BLOCK)
        causal = kpos[None, :] <= qpos[:, None]
        pr = jax.nn.softmax(jnp.where(causal, s, -jnp.inf), axis=-1)
        attn = pr[:, :, 0] - lam * pr[:, :, 1]
        return jnp.einsum('bhqk,bhkv->bhqv', attn.astype(v.dtype), v)

    out = lax.map(block, (_to_blocks(q), jnp.arange(seq // Q_BLOCK)))
    return _from_blocks(out)


def setup_inputs(seed: int = 0) -> dict:
    key = jax.random.key(seed)
    ks = jax.random.split(key, 20)

    def nrm(k, shape, scale):
        return jax.random.normal(k, shape, jnp.float32) * scale

    return {
        'x': nrm(ks[0], (BATCH, SEQ, D_MODEL), 1.0),
        'p': nrm(ks[1], (DEPTH, BATCH, SEQ, PLE_DIM), 1.0),
        'norm_w': 1.0 + nrm(ks[2], (DEPTH, D_MODEL), 0.05),
        'w_in': nrm(ks[3], (DEPTH, D_MODEL, IN_W), D_MODEL ** -0.5),
        'b_gate': nrm(ks[4], (DEPTH, N_BRANCH * D_MODEL), 0.01),
        'conv_w': nrm(ks[5], (DEPTH, CONV_WIDTH, CONV_DIM), CONV_WIDTH ** -0.5),
        'diff_q_norm': 1.0 + nrm(ks[6], (DEPTH, DIFF_HEAD_DIM), 0.05),
        'diff_k_norm': 1.0 + nrm(ks[7], (DEPTH, DIFF_HEAD_DIM), 0.05),
        'lam_q1': nrm(ks[8], (DEPTH, DIFF_HEAD_DIM), 0.1),
        'lam_k1': nrm(ks[9], (DEPTH, DIFF_HEAD_DIM), 0.1),
        'lam_q2': nrm(ks[10], (DEPTH, DIFF_HEAD_DIM), 0.1),
        'lam_k2': nrm(ks[11], (DEPTH, DIFF_HEAD_DIM), 0.1),
        'diff_subln': 1.0 + nrm(ks[12], (DEPTH, DIFF_V_DIM), 0.05),
        'w_out_conv': nrm(ks[13], (DEPTH, CONV_DIM, D_MODEL), CONV_DIM ** -0.5),
        'w_out_sb': nrm(ks[14], (DEPTH, SB_HEADS * SB_HEAD_DIM, D_MODEL), (SB_HEADS * SB_HEAD_DIM) ** -0.5),
        'w_out_diff': nrm(ks[15], (DEPTH, DIFF_HEADS * DIFF_V_DIM, D_MODEL), (DIFF_HEADS * DIFF_V_DIM) ** -0.5),
        'w_out': nrm(ks[16], (DEPTH, D_MODEL, D_MODEL), D_MODEL ** -0.5),
        'ple_norm': 1.0 + nrm(ks[17], (DEPTH, D_MODEL), 0.05),
        'w_ple_gate': nrm(ks[18], (DEPTH, D_MODEL, D_MODEL), D_MODEL ** -0.5),
        'w_ple': nrm(ks[19], (DEPTH, PLE_DIM, D_MODEL), PLE_DIM ** -0.5),
    }


def reference(x, p, norm_w, w_in, b_gate, conv_w, diff_q_norm, diff_k_norm,
              lam_q1, lam_k1, lam_q2, lam_k2, diff_subln, w_out_conv, w_out_sb,
              w_out_diff, w_out, ple_norm, w_ple_gate, w_ple):
    b, s, _ = x.shape
    cos, sin = _rope_tables(s, DIFF_HEAD_DIM, x.dtype)
    pts = _split_points()
    for i in range(DEPTH):
        xn = _rmsnorm(x, norm_w[i])
        proj = xn @ w_in[i]
        (c_b, c_c, c_u, c_z, s_q, s_k, s_v, s_z,
         d_q, d_k, d_v, d_z, g_logits) = jnp.split(proj, pts, axis=-1)

        y_a = c_b * _causal_conv(c_c * c_u, conv_w[i])
        y_a = (y_a * jax.nn.silu(c_z)) @ w_out_conv[i]

        def heads_sb(t):
            return t.reshape(b, s, SB_HEADS, SB_HEAD_DIM).transpose(0, 2, 1, 3)
        o_b = _stick_breaking_attention(heads_sb(s_q), heads_sb(s_k), heads_sb(s_v))
        o_b = o_b.transpose(0, 2, 1, 3).reshape(b, s, SB_HEADS * SB_HEAD_DIM)
        y_b = (o_b * jax.nn.silu(s_z)) @ w_out_sb[i]

        lam_init = 0.8 - 0.6 * math.exp(-0.3 * i)
        lam = (jnp.exp(jnp.sum(lam_q1[i].astype(jnp.float32) * lam_k1[i].astype(jnp.float32)))
               - jnp.exp(jnp.sum(lam_q2[i].astype(jnp.float32) * lam_k2[i].astype(jnp.float32)))
               + lam_init)
        qd = d_q.reshape(b, s, DIFF_HEADS, 2, DIFF_HEAD_DIM).transpose(0, 2, 3, 1, 4)
        kd = d_k.reshape(b, s, DIFF_HEADS, 2, DIFF_HEAD_DIM).transpose(0, 2, 3, 1, 4)
        qd = _rope(_rmsnorm(qd, diff_q_norm[i]), cos, sin)
        kd = _rope(_rmsnorm(kd, diff_k_norm[i]), cos, sin)
        vd = d_v.reshape(b, s, DIFF_HEADS, DIFF_V_DIM).transpose(0, 2, 1, 3)
        o_c = _diff_attention(qd, kd, vd, lam)
        o_c = _rmsnorm(o_c, diff_subln[i]) * (1.0 - lam_init)
        o_c = o_c.transpose(0, 2, 1, 3).reshape(b, s, DIFF_HEADS * DIFF_V_DIM)
        y_c = (o_c * jax.nn.silu(d_z)) @ w_out_diff[i]

        g = jax.nn.sigmoid(g_logits + b_gate[i]).reshape(b, s, N_BRANCH, D_MODEL)
        h = g[:, :, 0] * y_a + g[:, :, 1] * y_b + g[:, :, 2] * y_c
        x = x + h @ w_out[i]

        pg = jax.nn.sigmoid(_rmsnorm(x, ple_norm[i]) @ w_ple_gate[i])
        x = x + pg * (p[i] @ w_ple[i])
    return x
```

```cpp
#include <hip/hip_runtime.h>
#include <hip/hip_cooperative_groups.h>
#include <cstdio>
#include <cstdint>
namespace cg = cooperative_groups;

#ifndef MK_MULTI
#define MK_MULTI 0
#endif
#ifndef PROBE_DUP
#define PROBE_DUP -1
#endif

typedef unsigned short bf16_t;
typedef short bf16x8 __attribute__((ext_vector_type(8)));
typedef float f32x16 __attribute__((ext_vector_type(16)));
typedef float f32x4 __attribute__((ext_vector_type(4)));
typedef float f32x2 __attribute__((ext_vector_type(2)));
typedef unsigned u32x4 __attribute__((ext_vector_type(4)));
typedef unsigned u32x2 __attribute__((ext_vector_type(2)));
typedef __bf16 bf2_t __attribute__((ext_vector_type(2)));
#define DI __device__ __forceinline__
#define MFMA(a, b, c) __builtin_amdgcn_mfma_f32_32x32x16_bf16((a), (b), (c), 0, 0, 0)

constexpr int kB = 4, kS = 8192, kT = kB * kS;
constexpr float kEps = 1e-6f;
constexpr float kLog2e = 1.4426950408889634f;
constexpr float kLn2 = 0.6931471805599453f;
constexpr size_t MiB = 1u << 20;
constexpr size_t OFF_COS = 0, OFF_SIN = 1 * MiB, OFF_WT = 4 * MiB, OFF_XN = 56 * MiB, OFF_HB = 120 * MiB, OFF_PROJ = 184 * MiB;
constexpr size_t PROJ_SLOT = 32 * MiB;
constexpr size_t OFF_SSQA = 2 * MiB, OFF_SSQB = 504 * MiB, OFF_BAR = 506 * MiB;
constexpr size_t WS_NEED = 507 * MiB;
enum { SL_CU = 0, SL_BZ = 1, SL_SQ = 2, SL_DQ = 3, SL_SK = 4, SL_SVT = 5, SL_SZ = 6, SL_DK = 7, SL_DVT = 8, SL_DZ = 9 };
constexpr int LDS_RS = 131072;
constexpr size_t W_IN = 0, W_G = W_IN + 6144 * 1024, W_OC = W_G + 3072 * 1024, W_OSB = W_OC + 512 * 1024, W_OD = W_OSB + 512 * 1024,
                 W_OUT = W_OD + 512 * 1024, W_PG = W_OUT + 1024 * 1024, W_PLE = W_PG + 1024 * 1024, W_LAYER = W_PLE + 256 * 1024;
constexpr int LDS_XB = 132096;
constexpr int LDS_BYTES = 133120;

struct Params {
    const float* x; const float* p; const float* norm_w; const float* w_in; const float* b_gate; const float* conv_w;
    const float* dqn; const float* dkn; const float* lq1; const float* lk1; const float* lq2; const float* lk2;
    const float* subln; const float* w_oc; const float* w_osb; const float* w_od; const float* w_out; const float* ple_norm;
    const float* w_pg; const float* w_ple;
    float* out; char* ws;
    int ph_lo, ph_hi;
};

DI int tid() { int t = __builtin_amdgcn_workitem_id_x(); asm volatile("" : "+v"(t)); return t; }
DI unsigned pk2(float a, float b) { f32x2 v = {a, b}; return __builtin_bit_cast(unsigned, __builtin_convertvector(v, bf2_t)); }
DI float bf_lo(unsigned u) { return __uint_as_float(u << 16); }
DI float bf_hi(unsigned u) { return __uint_as_float(u & 0xffff0000u); }
DI float fexp2(float x) { return __builtin_amdgcn_exp2f(x); }
DI float flog2(float x) { return __builtin_amdgcn_logf(x); }
DI float frcp(float x) { return __builtin_amdgcn_rcpf(x); }
DI float sigm(float x) { return frcp(1.f + fexp2(-kLog2e * x)); }
DI float silu(float x) { return x * sigm(x); }
DI bf16_t* slotp(const Params& P, int s) { return (bf16_t*)(P.ws + OFF_PROJ + (size_t)s * PROJ_SLOT); }
DI bf16_t* wtp(const Params& P, int layer, size_t off) { return (bf16_t*)(P.ws + OFF_WT) + (size_t)layer * W_LAYER + off; }

DI void st16(bf16_t* dst, const f32x16& v) {
    u32x4 a = {pk2(v[0], v[1]), pk2(v[2], v[3]), pk2(v[4], v[5]), pk2(v[6], v[7])};
    u32x4 b = {pk2(v[8], v[9]), pk2(v[10], v[11]), pk2(v[12], v[13]), pk2(v[14], v[15])};
    *(u32x4*)dst = a; *(u32x4*)(dst + 8) = b;
}
DI f32x16 zero16() { f32x16 z; for (int i = 0; i < 16; ++i) z[i] = 0.f; return z; }
DI f32x16 splat16(float v) { f32x16 z; for (int i = 0; i < 16; ++i) z[i] = v; return z; }

typedef __attribute__((address_space(3))) void* lds_ptr_t;
#define MFMA16(a, b, c) __builtin_amdgcn_mfma_f32_16x16x32_bf16((a), (b), (c), 0, 0, 0)
DI int lds_byte(int r, int c) { const int st = (r >> 4) * 2 + (c >> 5), rr = r & 15, cc = c & 31, ob = rr * 64 + cc * 2; return st * 1024 + (ob ^ (((ob >> 9) & 1) << 5)); }
DI void stage_rc(int b, int& R, int& C) { const int st = b / 1024, sb = b % 1024, swz = sb ^ (((sb >> 9) & 1) << 5); R = (st >> 1) * 16 + swz / 64; C = (st & 1) * 32 + (swz % 64) / 2; }

DI void gemm8(f32x4 (&acc)[2][2][4][2], const bf16_t* __restrict__ Rm, const bf16_t* __restrict__ Cm, int K, char* shm) {
    constexpr int HT2 = 128 * 64 * 2;
    const int t = tid(), wid = t >> 6, lane = t & 63, wr = wid >> 2, wc = wid & 3, fr = lane & 15, fq = lane >> 4;
#define SA(b, hh) (shm + ((b) * 2 + (hh)) * HT2)
#define SB(b, hh) (shm + (4 + (b) * 2 + (hh)) * HT2)
    int gofs[2];
#pragma unroll
    for (int i = 0; i < 2; ++i) { int r_, c_; stage_rc(t * 16 + i * 8192, r_, c_); gofs[i] = r_ * K + c_; }
    const int wb = wid * 1024;
#define STAGE(P, BASE, br, kt) do { const bf16_t* g_ = (BASE) + (size_t)(br) * K + (size_t)(kt) * 64; \
        _Pragma("unroll") for (int i_ = 0; i_ < 2; ++i_) \
            __builtin_amdgcn_global_load_lds((const unsigned*)(g_ + gofs[i_]), (lds_ptr_t)((P) + wb + i_ * 8192), 16, 0, 0); } while (0)
#define LDA(dst, b, hh) _Pragma("unroll") for (int m = 0; m < 4; ++m) _Pragma("unroll") for (int k = 0; k < 2; ++k) \
        dst[m][k] = *(const bf16x8*)(SA(b, hh) + lds_byte(wr * 64 + m * 16 + fr, k * 32 + fq * 8))
#define LDB(dst, b, hh) _Pragma("unroll") for (int n = 0; n < 2; ++n) _Pragma("unroll") for (int k = 0; k < 2; ++k) \
        dst[n][k] = *(const bf16x8*)(SB(b, hh) + lds_byte(wc * 32 + n * 16 + fr, k * 32 + fq * 8))
#define MMA(ai, bj, At_, Bt_) do { __builtin_amdgcn_s_setprio(1); \
        _Pragma("unroll") for (int m = 0; m < 4; ++m) _Pragma("unroll") for (int n = 0; n < 2; ++n) _Pragma("unroll") for (int k = 0; k < 2; ++k) \
            acc[ai][bj][m][n] = MFMA16(At_[m][k], Bt_[n][k], acc[ai][bj][m][n]); \
        __builtin_amdgcn_s_setprio(0); } while (0)
#define WAIT_V(n) asm volatile("s_waitcnt vmcnt(" #n ")" ::: "memory")
#define WAIT_L(n) asm volatile("s_waitcnt lgkmcnt(" #n ")" ::: "memory")
#define BAR __builtin_amdgcn_s_barrier()
#define SCHED __builtin_amdgcn_sched_barrier(0)
#pragma unroll
    for (int a_ = 0; a_ < 2; ++a_)
#pragma unroll
        for (int b_ = 0; b_ < 2; ++b_)
#pragma unroll
            for (int m = 0; m < 4; ++m) { acc[a_][b_][m][0] = (f32x4){0.f, 0.f, 0.f, 0.f}; acc[a_][b_][m][1] = (f32x4){0.f, 0.f, 0.f, 0.f}; }
    bf16x8 At[4][2], B0[2][2], B1[2][2];
    const int nt = K >> 6;
    STAGE(SB(0, 0), Cm, 0, 0); STAGE(SA(0, 0), Rm, 0, 0);
    STAGE(SB(0, 1), Cm, 128, 0); STAGE(SA(0, 1), Rm, 128, 0);
    if (wr == 1) BAR;
    WAIT_V(4); BAR;
    STAGE(SB(1, 0), Cm, 0, 1); STAGE(SA(1, 0), Rm, 0, 1); STAGE(SB(1, 1), Cm, 128, 1);
    WAIT_V(6); BAR;
    for (int tt = 0; tt < nt - 2; tt += 2) {
        LDB(B0, 0, 0); SCHED; LDA(At, 0, 0); STAGE(SA(1, 1), Rm, 128, tt + 1);
        WAIT_L(8); BAR; WAIT_L(0); MMA(0, 0, At, B0); BAR; SCHED;
        LDB(B1, 0, 1); STAGE(SB(0, 0), Cm, 0, tt + 2);
        BAR; WAIT_L(0); MMA(0, 1, At, B1); BAR;
        LDA(At, 0, 1); STAGE(SA(0, 0), Rm, 0, tt + 2);
        BAR; WAIT_L(0); MMA(1, 0, At, B0); BAR; SCHED;
        STAGE(SB(0, 1), Cm, 128, tt + 2);
        WAIT_V(6); BAR; MMA(1, 1, At, B1); BAR;
        LDB(B0, 1, 0); SCHED; LDA(At, 1, 0); STAGE(SA(0, 1), Rm, 128, tt + 2);
        WAIT_L(8); BAR; WAIT_L(0); MMA(0, 0, At, B0); BAR; SCHED;
        LDB(B1, 1, 1); STAGE(SB(1, 0), Cm, 0, tt + 3);
        BAR; WAIT_L(0); MMA(0, 1, At, B1); BAR;
        LDA(At, 1, 1); STAGE(SA(1, 0), Rm, 0, tt + 3);
        BAR; WAIT_L(0); MMA(1, 0, At, B0); BAR; SCHED;
        STAGE(SB(1, 1), Cm, 128, tt + 3);
        WAIT_V(6); BAR; MMA(1, 1, At, B1); BAR;
    }
    { LDB(B0, 0, 0); LDA(At, 0, 0); STAGE(SA(1, 1), Rm, 128, nt - 1);
      BAR; WAIT_L(0); MMA(0, 0, At, B0); BAR;
      LDB(B1, 0, 1); BAR; WAIT_L(0); MMA(0, 1, At, B1); BAR;
      LDA(At, 0, 1); WAIT_V(4); BAR; WAIT_L(0); MMA(1, 0, At, B0); MMA(1, 1, At, B1); BAR; }
    { LDB(B0, 1, 0); LDA(At, 1, 0); WAIT_V(2); BAR; WAIT_L(0); MMA(0, 0, At, B0); BAR;
      LDB(B1, 1, 1); WAIT_V(0); BAR; WAIT_L(0); MMA(0, 1, At, B1); BAR;
      LDA(At, 1, 1); BAR; WAIT_L(0); MMA(1, 0, At, B0); MMA(1, 1, At, B1); BAR; }
    if (wr == 0) BAR;
#undef SA
#undef SB
#undef STAGE
#undef LDA
#undef LDB
#undef MMA
}

template <class Hook>
DI void gemm8_cat3(f32x4 (&acc)[2][2][4][2], const bf16_t* R0, const bf16_t* R1, const bf16_t* R2, const bf16_t* C0, const bf16_t* C1, const bf16_t* C2, char* shm, Hook hook) {
    constexpr int K = 512;
    constexpr int HT2 = 128 * 64 * 2;
    const int t = tid(), wid = t >> 6, lane = t & 63, wr = wid >> 2, wc = wid & 3, fr = lane & 15, fq = lane >> 4;
#define SA(b, hh) (shm + ((b) * 2 + (hh)) * HT2)
#define SB(b, hh) (shm + (4 + (b) * 2 + (hh)) * HT2)
    int gofs[2];
#pragma unroll
    for (int i = 0; i < 2; ++i) { int r_, c_; stage_rc(t * 16 + i * 8192, r_, c_); gofs[i] = r_ * K + c_; }
    const int wb = wid * 1024;
#define STAGE(P, BASE, br, kt) do { const int sg_ = (kt) >> 3; const bf16_t* g_ = (sg_ == 0 ? BASE##0 : sg_ == 1 ? BASE##1 : BASE##2) + (size_t)(br) * K + (size_t)((kt) & 7) * 64; \
        _Pragma("unroll") for (int i_ = 0; i_ < 2; ++i_) \
            __builtin_amdgcn_global_load_lds((const unsigned*)(g_ + gofs[i_]), (lds_ptr_t)((P) + wb + i_ * 8192), 16, 0, 0); } while (0)
#define LDA(dst, b, hh) _Pragma("unroll") for (int m = 0; m < 4; ++m) _Pragma("unroll") for (int k = 0; k < 2; ++k) \
        dst[m][k] = *(const bf16x8*)(SA(b, hh) + lds_byte(wr * 64 + m * 16 + fr, k * 32 + fq * 8))
#define LDB(dst, b, hh) _Pragma("unroll") for (int n = 0; n < 2; ++n) _Pragma("unroll") for (int k = 0; k < 2; ++k) \
        dst[n][k] = *(const bf16x8*)(SB(b, hh) + lds_byte(wc * 32 + n * 16 + fr, k * 32 + fq * 8))
#define MMA(ai, bj, At_, Bt_) do { __builtin_amdgcn_s_setprio(1); \
        _Pragma("unroll") for (int m = 0; m < 4; ++m) _Pragma("unroll") for (int n = 0; n < 2; ++n) _Pragma("unroll") for (int k = 0; k < 2; ++k) \
            acc[ai][bj][m][n] = MFMA16(At_[m][k], Bt_[n][k], acc[ai][bj][m][n]); \
        __builtin_amdgcn_s_setprio(0); } while (0)
#define WAIT_V(n) asm volatile("s_waitcnt vmcnt(" #n ")" ::: "memory")
#define WAIT_L(n) asm volatile("s_waitcnt lgkmcnt(" #n ")" ::: "memory")
#define BAR __builtin_amdgcn_s_barrier()
#define SCHED __builtin_amdgcn_sched_barrier(0)
#pragma unroll
    for (int a_ = 0; a_ < 2; ++a_)
#pragma unroll
        for (int b_ = 0; b_ < 2; ++b_)
#pragma unroll
            for (int m = 0; m < 4; ++m) { acc[a_][b_][m][0] = (f32x4){0.f, 0.f, 0.f, 0.f}; acc[a_][b_][m][1] = (f32x4){0.f, 0.f, 0.f, 0.f}; }
    bf16x8 At[4][2], B0[2][2], B1[2][2];
    const int nt = 24;
    STAGE(SB(0, 0), C, 0, 0); STAGE(SA(0, 0), R, 0, 0);
    STAGE(SB(0, 1), C, 128, 0); STAGE(SA(0, 1), R, 128, 0);
    if (wr == 1) BAR;
    WAIT_V(4); BAR;
    STAGE(SB(1, 0), C, 0, 1); STAGE(SA(1, 0), R, 0, 1); STAGE(SB(1, 1), C, 128, 1);
    WAIT_V(6); BAR;
#pragma unroll 1
    for (int tt = 0; tt < 8; tt += 2) {
        LDB(B0, 0, 0); SCHED; LDA(At, 0, 0); STAGE(SA(1, 1), R, 128, tt + 1);
        WAIT_L(8); BAR; WAIT_L(0); MMA(0, 0, At, B0); BAR; SCHED;
        LDB(B1, 0, 1); STAGE(SB(0, 0), C, 0, tt + 2);
        BAR; WAIT_L(0); MMA(0, 1, At, B1); BAR;
        LDA(At, 0, 1); STAGE(SA(0, 0), R, 0, tt + 2);
        BAR; WAIT_L(0); MMA(1, 0, At, B0); BAR; SCHED;
        STAGE(SB(0, 1), C, 128, tt + 2);
        WAIT_V(6); BAR; MMA(1, 1, At, B1); BAR;
        LDB(B0, 1, 0); SCHED; LDA(At, 1, 0); STAGE(SA(0, 1), R, 128, tt + 2);
        WAIT_L(8); BAR; WAIT_L(0); MMA(0, 0, At, B0); BAR; SCHED;
        LDB(B1, 1, 1); STAGE(SB(1, 0), C, 0, tt + 3);
        BAR; WAIT_L(0); MMA(0, 1, At, B1); BAR;
        LDA(At, 1, 1); STAGE(SA(1, 0), R, 0, tt + 3);
        BAR; WAIT_L(0); MMA(1, 0, At, B0); BAR; SCHED;
        STAGE(SB(1, 1), C, 128, tt + 3);
        WAIT_V(6); BAR; MMA(1, 1, At, B1); BAR;
    }
    hook(0);
#pragma unroll 1
    for (int tt = 8; tt < 16; tt += 2) {
        LDB(B0, 0, 0); SCHED; LDA(At, 0, 0); STAGE(SA(1, 1), R, 128, tt + 1);
        WAIT_L(8); BAR; WAIT_L(0); MMA(0, 0, At, B0); BAR; SCHED;
        LDB(B1, 0, 1); STAGE(SB(0, 0), C, 0, tt + 2);
        BAR; WAIT_L(0); MMA(0, 1, At, B1); BAR;
        LDA(At, 0, 1); STAGE(SA(0, 0), R, 0, tt + 2);
        BAR; WAIT_L(0); MMA(1, 0, At, B0); BAR; SCHED;
        STAGE(SB(0, 1), C, 128, tt + 2);
        WAIT_V(6); BAR; MMA(1, 1, At, B1); BAR;
        LDB(B0, 1, 0); SCHED; LDA(At, 1, 0); STAGE(SA(0, 1), R, 128, tt + 2);
        WAIT_L(8); BAR; WAIT_L(0); MMA(0, 0, At, B0); BAR; SCHED;
        LDB(B1, 1, 1); STAGE(SB(1, 0), C, 0, tt + 3);
        BAR; WAIT_L(0); MMA(0, 1, At, B1); BAR;
        LDA(At, 1, 1); STAGE(SA(1, 0), R, 0, tt + 3);
        BAR; WAIT_L(0); MMA(1, 0, At, B0); BAR; SCHED;
        STAGE(SB(1, 1), C, 128, tt + 3);
        WAIT_V(6); BAR; MMA(1, 1, At, B1); BAR;
    }
    hook(1);
#pragma unroll 1
    for (int tt = 16; tt < nt - 2; tt += 2) {
        LDB(B0, 0, 0); SCHED; LDA(At, 0, 0); STAGE(SA(1, 1), R, 128, tt + 1);
        WAIT_L(8); BAR; WAIT_L(0); MMA(0, 0, At, B0); BAR; SCHED;
        LDB(B1, 0, 1); STAGE(SB(0, 0), C, 0, tt + 2);
        BAR; WAIT_L(0); MMA(0, 1, At, B1); BAR;
        LDA(At, 0, 1); STAGE(SA(0, 0), R, 0, tt + 2);
        BAR; WAIT_L(0); MMA(1, 0, At, B0); BAR; SCHED;
        STAGE(SB(0, 1), C, 128, tt + 2);
        WAIT_V(6); BAR; MMA(1, 1, At, B1); BAR;
        LDB(B0, 1, 0); SCHED; LDA(At, 1, 0); STAGE(SA(0, 1), R, 128, tt + 2);
        WAIT_L(8); BAR; WAIT_L(0); MMA(0, 0, At, B0); BAR; SCHED;
        LDB(B1, 1, 1); STAGE(SB(1, 0), C, 0, tt + 3);
        BAR; WAIT_L(0); MMA(0, 1, At, B1); BAR;
        LDA(At, 1, 1); STAGE(SA(1, 0), R, 0, tt + 3);
        BAR; WAIT_L(0); MMA(1, 0, At, B0); BAR; SCHED;
        STAGE(SB(1, 1), C, 128, tt + 3);
        WAIT_V(6); BAR; MMA(1, 1, At, B1); BAR;
    }
    { LDB(B0, 0, 0); LDA(At, 0, 0); STAGE(SA(1, 1), R, 128, nt - 1);
      BAR; WAIT_L(0); MMA(0, 0, At, B0); BAR;
      LDB(B1, 0, 1); BAR; WAIT_L(0); MMA(0, 1, At, B1); BAR;
      LDA(At, 0, 1); WAIT_V(4); BAR; WAIT_L(0); MMA(1, 0, At, B0); MMA(1, 1, At, B1); BAR; }
    { LDB(B0, 1, 0); LDA(At, 1, 0); WAIT_V(2); BAR; WAIT_L(0); MMA(0, 0, At, B0); BAR;
      LDB(B1, 1, 1); WAIT_V(0); BAR; WAIT_L(0); MMA(0, 1, At, B1); BAR;
      LDA(At, 1, 1); BAR; WAIT_L(0); MMA(1, 0, At, B0); MMA(1, 1, At, B1); BAR; }
    if (wr == 0) BAR;
#undef SA
#undef SB
#undef STAGE
#undef LDA
#undef LDB
#undef MMA
}

DI void grp16(const f32x4 (&acc)[2][2][4][2], int ai, int bj, int nn, float sc, float (&lo)[8], float (&hi)[8]) {
#pragma unroll
    for (int j = 0; j < 4; ++j) {
        lo[j] = acc[ai][bj][0][nn][j] * sc; lo[4 + j] = acc[ai][bj][1][nn][j] * sc;
        hi[j] = acc[ai][bj][2][nn][j] * sc; hi[4 + j] = acc[ai][bj][3][nn][j] * sc;
    }
}
DI void st8(bf16_t* dst, const float (&v)[8]) { u32x4 o = {pk2(v[0], v[1]), pk2(v[2], v[3]), pk2(v[4], v[5]), pk2(v[6], v[7])}; *(u32x4*)dst = o; }

DI void tile_map(int t, int& mt, int& nt) {
    const int round = t >> 8, b = t & 255, x = b & 7, j = b >> 3;
    const int rg = round & 1, cgp = round >> 1;
    mt = 64 * rg + 8 * x + (j & 7); nt = 4 * cgp + (j >> 3);
}

DI void tile_rstd(const float* __restrict__ ssq, int m0, char* lds) {
    __syncthreads();
    const int t = tid();
    if (t < 256) {
        const f32x4* p = (const f32x4*)(ssq + (size_t)(m0 + t) * 16);
        const f32x4 a = p[0], b = p[1], c = p[2], d = p[3];
        const float sm = ((a[0] + a[1]) + (a[2] + a[3])) + ((b[0] + b[1]) + (b[2] + b[3])) + ((c[0] + c[1]) + (c[2] + c[3])) + ((d[0] + d[1]) + (d[2] + d[3]));
        ((float*)(lds + LDS_RS))[t] = __builtin_amdgcn_rsqf(sm * (1.f / 1024.f) + kEps);
    }
}

DI int v2logical(int v) { const int m = (v >> 4) & 3, fq = (v >> 2) & 3, j = v & 3; return (v & ~63) + 32 * (m >> 1) + 8 * fq + 4 * (m & 1) + j; }
DI int inproj_actual(int L) {
    if (L < 1024) { const int i = L >> 8, w = L & 255; return (w < 128 ? 512 : 1024) + 128 * i + (w & 127); }
    if (L < 2048) { L -= 1024; const int i = L >> 8, w = L & 255; return (w < 128 ? 0 : 1536) + 128 * i + (w & 127); }
    return L;
}

DI void convert_job(const float* __restrict__ src, int ld, int K, int Nv, int mode, int coloff, const float* __restrict__ rowscale,
                    bf16_t* __restrict__ dst, char* lds) {
    float (*tl)[65] = (float (*)[65])lds;
    const int t = tid();
    const int tiles_k = K >> 6, tiles_v = Nv >> 6;
    for (int tile = blockIdx.x; tile < tiles_k * tiles_v; tile += gridDim.x) {
        const int tk = tile % tiles_k, tv = tile / tiles_k, k0 = tk * 64, v0 = tv * 64;
        {
            const int v = t & 63, kk = t >> 6;
            int L = v2logical(v0 + v);
            if (mode) { const int g = (v0 + v) >= 2048 ? ((v0 + v) - 2048) >> 9 : -1; if (g == 2 || g == 6) L = v0 + v; }
            const int col = mode ? inproj_actual(L) : coloff + L;
#pragma unroll
            for (int i = 0; i < 8; ++i) {
                const int k = kk + 8 * i;
                float xv = src[(size_t)(k0 + k) * ld + col];
                if (rowscale) xv *= rowscale[k0 + k];
                tl[k][v] = xv;
            }
        }
        __syncthreads();
        {
            const int vv = t >> 3, kc = t & 7;
            u32x4 o;
            o[0] = pk2(tl[8 * kc + 0][vv], tl[8 * kc + 1][vv]); o[1] = pk2(tl[8 * kc + 2][vv], tl[8 * kc + 3][vv]);
            o[2] = pk2(tl[8 * kc + 4][vv], tl[8 * kc + 5][vv]); o[3] = pk2(tl[8 * kc + 6][vv], tl[8 * kc + 7][vv]);
            *(u32x4*)(dst + (size_t)(v0 + vv) * K + k0 + 8 * kc) = o;
        }
        __syncthreads();
    }
}

DI void rope_tables(const Params& P) {
    float* ct = (float*)(P.ws + OFF_COS); float* sn = (float*)(P.ws + OFF_SIN);
    for (int idx = blockIdx.x * 512 + tid(); idx < kS * 32; idx += gridDim.x * 512) {
        const int pos = idx >> 5, i = idx & 31;
        const float inv = fexp2(-(float)i * (13.287712379549449f / 32.f));
        const float ang = (float)pos * inv;
        const double rev = (double)ang * 0.15915494309189535;
        const float fr = (float)(rev - floor(rev));
        ct[idx] = __builtin_amdgcn_cosf(fr); sn[idx] = __builtin_amdgcn_sinf(fr);
    }
}

DI void x_to_bf16_ssq(const float* __restrict__ src, bf16_t* __restrict__ dst, float* __restrict__ ssq) {
    const int lane = tid() & 63, wave = tid() >> 6;
    for (int row = blockIdx.x * 8 + wave; row < kT; row += gridDim.x * 8) {
        const f32x4* r = (const f32x4*)(src + (size_t)row * 1024);
        f32x4 v[4]; float ss = 0.f;
#pragma unroll
        for (int i = 0; i < 2; ++i) { v[2 * i] = r[2 * lane + 128 * i]; v[2 * i + 1] = r[2 * lane + 1 + 128 * i]; }
#pragma unroll
        for (int i = 0; i < 4; ++i) ss += v[i][0] * v[i][0] + v[i][1] * v[i][1] + v[i][2] * v[i][2] + v[i][3] * v[i][3];
#pragma unroll
        for (int o = 32; o >= 1; o >>= 1) ss += __shfl_xor(ss, o);
#pragma unroll
        for (int i = 0; i < 2; ++i) {
            u32x4 o = {pk2(v[2 * i][0], v[2 * i][1]), pk2(v[2 * i][2], v[2 * i][3]), pk2(v[2 * i + 1][0], v[2 * i + 1][1]), pk2(v[2 * i + 1][2], v[2 * i + 1][3])};
            *(u32x4*)(dst + (size_t)row * 1024 + 8 * lane + 512 * i) = o;
        }
        if (lane < 16) ssq[(size_t)row * 16 + lane] = lane == 0 ? ss : 0.f;
    }
}

DI void p_to_bf16(const float* __restrict__ src, bf16_t* __restrict__ dst) {
    const size_t n8 = (size_t)kT * 256 / 8;
    for (size_t i = (size_t)blockIdx.x * 512 + tid(); i < n8; i += (size_t)gridDim.x * 512) {
        const f32x4 a = ((const f32x4*)src)[2 * i], b = ((const f32x4*)src)[2 * i + 1];
        u32x4 o = {pk2(a[0], a[1]), pk2(a[2], a[3]), pk2(b[0], b[1]), pk2(b[2], b[3])};
        ((u32x4*)dst)[i] = o;
    }
}

#define LANE_DECODE const int t_ = tid(), wid = t_ >> 6, lane = t_ & 63, wr = wid >> 2, wc = wid & 3, fr = lane & 15, fq = lane >> 4

DI void inproj_epilogue(const Params& P, int layer, const f32x4 (&acc)[2][2][4][2], int m0, int n0, const char* lds) {
    LANE_DECODE; (void)lane;
    const float* rsl = (const float*)(lds + LDS_RS);
#pragma unroll
    for (int bj = 0; bj < 2; ++bj)
#pragma unroll
        for (int nn = 0; nn < 2; ++nn) {
            const int rl = bj * 128 + wc * 32 + nn * 16 + fr;
            const size_t tok = (size_t)m0 + rl;
            const float rr = rsl[rl];
            if (n0 < 2048) {
                float l0[8], h0[8], l1[8], h1[8];
                grp16(acc, 0, bj, nn, rr, l0, h0); grp16(acc, 1, bj, nn, rr, l1, h1);
                const bool iscu = n0 < 1024;
                const int ch = 128 * ((iscu ? n0 : n0 - 1024) >> 8) + 64 * wr + 8 * fq;
#pragma unroll
                for (int i = 0; i < 8; ++i) { l0[i] *= iscu ? l1[i] : silu(l1[i]); h0[i] *= iscu ? h1[i] : silu(h1[i]); }
                bf16_t* d = slotp(P, iscu ? SL_CU : SL_BZ) + tok * 512 + ch;
                st8(d, l0); st8(d + 32, h0);
            } else {
#pragma unroll
                for (int ai = 0; ai < 2; ++ai) {
                    const int ncol = n0 + ai * 128 + wr * 64;
                    const int grp = (ncol - 2048) >> 9, cin = (ncol - 2048) & 511;
                    float lo[8], hi[8];
                    grp16(acc, ai, bj, nn, rr, lo, hi);
                    if (grp == 0 || grp == 1) {
                        if (grp == 0) {
#pragma unroll
                            for (int i = 0; i < 8; ++i) { lo[i] *= 0.125f * kLog2e; hi[i] *= 0.125f * kLog2e; }
                        }
                        bf16_t* d = slotp(P, grp == 0 ? SL_SQ : SL_SK) + tok * 512 + cin + 8 * fq;
                        st8(d, lo); st8(d + 32, hi);
                    } else if (grp == 3 || grp == 7) {
#pragma unroll
                        for (int i = 0; i < 8; ++i) { lo[i] = silu(lo[i]); hi[i] = silu(hi[i]); }
                        bf16_t* d = slotp(P, grp == 3 ? SL_SZ : SL_DZ) + tok * 512 + cin + 8 * fq;
                        st8(d, lo); st8(d + 32, hi);
                    } else {
                        const float* wv = (grp == 4 ? P.dqn : P.dkn) + layer * 64;
                        float ss = 0.f;
#pragma unroll
                        for (int i = 0; i < 8; ++i) ss += lo[i] * lo[i] + hi[i] * hi[i];
                        ss += __shfl_xor(ss, 16); ss += __shfl_xor(ss, 32);
                        const float rs = __builtin_amdgcn_rsqf(ss * (1.f / 64.f) + kEps);
                        const float osc = grp == 4 ? 0.125f * kLog2e : 1.f;
                        const int pos = (int)(tok & (kS - 1));
                        const float* cp = (const float*)(P.ws + OFF_COS) + pos * 32 + 8 * fq;
                        const float* sp = (const float*)(P.ws + OFF_SIN) + pos * 32 + 8 * fq;
#pragma unroll
                        for (int q4 = 0; q4 < 2; ++q4) {
                            const f32x4 c4 = *(const f32x4*)(cp + 4 * q4), s4 = *(const f32x4*)(sp + 4 * q4);
                            const f32x4 w0 = *(const f32x4*)(wv + 8 * fq + 4 * q4), w1 = *(const f32x4*)(wv + 32 + 8 * fq + 4 * q4);
#pragma unroll
                            for (int j = 0; j < 4; ++j) {
                                const int i = 4 * q4 + j;
                                const float y0 = lo[i] * rs * w0[j], y1 = hi[i] * rs * w1[j];
                                lo[i] = (y0 * c4[j] - y1 * s4[j]) * osc; hi[i] = (y0 * s4[j] + y1 * c4[j]) * osc;
                            }
                        }
                        bf16_t* d = slotp(P, grp == 4 ? SL_DQ : SL_DK) + tok * 512 + cin + 8 * fq;
                        st8(d, lo); st8(d + 32, hi);
                    }
                }
            }
            __builtin_amdgcn_sched_barrier(0);
        }
}

DI void vT_epilogue(const Params& P, const f32x4 (&acc)[2][2][4][2], int m0, int n0, const char* lds) {
    LANE_DECODE; (void)lane;
    const float* rsl = (const float*)(lds + LDS_RS);
    const int grp = (n0 - 2048) >> 9;
#pragma unroll
    for (int ai = 0; ai < 2; ++ai)
#pragma unroll
        for (int m = 0; m < 4; ++m) {
            const int rb0 = ai * 128 + wr * 64 + m * 16;
            const int tb = m0 + rb0, b = tb / kS, pos0 = tb & (kS - 1);
            const f32x4 r4 = *(const f32x4*)(rsl + rb0 + 4 * fq);
            const int tp = 4 * (fq >> 1) + 8 * (fq & 1);
#pragma unroll
            for (int bj = 0; bj < 2; ++bj)
#pragma unroll
                for (int nn = 0; nn < 2; ++nn) {
                    const int cin = (n0 - 2048 + bj * 128 + wc * 32 + nn * 16 + fr) & 511;
                    bf16_t* rowp = grp == 2 ? slotp(P, SL_SVT) + ((size_t)(b * 8 + (cin >> 6)) * 64 + (cin & 63)) * kS + pos0
                                            : slotp(P, SL_DVT) + ((size_t)(b * 4 + (cin >> 7)) * 128 + (cin & 127)) * kS + pos0;
                    const f32x4 v = acc[ai][bj][m][nn];
                    u32x2 o = {pk2(v[0] * r4[0], v[1] * r4[1]), pk2(v[2] * r4[2], v[3] * r4[3])};
                    *(u32x2*)(rowp + tp) = o;
                }
        }
}

DI void inproj_phase(const Params& P, int layer, char* lds) {
    const bf16_t* xb = (const bf16_t*)(P.ws + ((layer & 1) ? OFF_HB : OFF_XN));
    const float* ssq = (const float*)(P.ws + OFF_SSQA);
    const bf16_t* wt = wtp(P, layer, W_IN);
    for (int t = blockIdx.x; t < 128 * 24; t += gridDim.x) {
        int mt, nt; tile_map(t, mt, nt);
        const int m0 = mt * 256, n0 = nt * 256;
        tile_rstd(ssq, m0, lds);
        f32x4 acc[2][2][4][2];
        const int grp = n0 >= 2048 ? (n0 - 2048) >> 9 : -1;
        if (grp == 2 || grp == 6) {
            gemm8(acc, xb + (size_t)m0 * 1024, wt + (size_t)n0 * 1024, 1024, lds);
            __syncthreads();
            vT_epilogue(P, acc, m0, n0, lds);
        } else {
            gemm8(acc, wt + (size_t)n0 * 1024, xb + (size_t)m0 * 1024, 1024, lds);
            __syncthreads();
            inproj_epilogue(P, layer, acc, m0, n0, lds);
        }
    }
}

DI void conv_pass(const Params& P, int layer) {
    const bf16_t* cu = slotp(P, SL_CU); bf16_t* bz = slotp(P, SL_BZ);
    const float* cw = P.conv_w + layer * 3 * 512;
    for (int idx = blockIdx.x * 512 + tid(); idx < kT * 64; idx += gridDim.x * 512) {
        const int tok = idx >> 6, c8 = (idx & 63) * 8, pos = tok & (kS - 1);
        const u32x4 z4 = {0u, 0u, 0u, 0u};
        const u32x4 c2 = *(const u32x4*)(cu + (size_t)tok * 512 + c8);
        const u32x4 c1 = pos >= 1 ? *(const u32x4*)(cu + (size_t)(tok - 1) * 512 + c8) : z4;
        const u32x4 c0 = pos >= 2 ? *(const u32x4*)(cu + (size_t)(tok - 2) * 512 + c8) : z4;
        const u32x4 bv = *(const u32x4*)(bz + (size_t)tok * 512 + c8);
        u32x4 o;
#pragma unroll
        for (int j = 0; j < 4; ++j) {
            const int ch = c8 + 2 * j;
            const float r0 = bf_lo(bv[j]) * (cw[ch] * bf_lo(c0[j]) + cw[512 + ch] * bf_lo(c1[j]) + cw[1024 + ch] * bf_lo(c2[j]));
            const float r1 = bf_hi(bv[j]) * (cw[ch + 1] * bf_hi(c0[j]) + cw[512 + ch + 1] * bf_hi(c1[j]) + cw[1024 + ch + 1] * bf_hi(c2[j]));
            o[j] = pk2(r0, r1);
        }
        *(u32x4*)(bz + (size_t)tok * 512 + c8) = o;
    }
}

DI bf16x8 pack8(const f32x16& v, int s) {
    u32x4 p = {pk2(v[8 * s], v[8 * s + 1]), pk2(v[8 * s + 2], v[8 * s + 3]), pk2(v[8 * s + 4], v[8 * s + 5]), pk2(v[8 * s + 6], v[8 * s + 7])};
    return __builtin_bit_cast(bf16x8, p);
}

DI void diff_pass(const bf16_t* __restrict__ qrow  , const bf16_t* __restrict__ kg, const bf16_t* __restrict__ vg,
                  int nkt, int q0, float negM2, f32x16 (&O)[4], float& lsum, char* lds) {
    const int t = tid(), lane = t & 63, wv = t >> 6, h = lane >> 5, l31 = lane & 31, f = (lane >> 1) & 7;
    const int lr = t >> 3, lc = t & 7;
    const int sc = (lc ^ ((lr >> 1) & 7)) - lc;
    const bf16_t* kgs = kg + sc * 8;
    const bf16_t* vgs = vg + sc * 8;
    const int wb = wv * 1024;
    const int qpos = q0 + l31;
    bf16x8 qf[4];
#pragma unroll
    for (int ks = 0; ks < 4; ++ks) qf[ks] = *(const bf16x8*)(qrow + 16 * ks + 8 * h);
#pragma unroll
    for (int d = 0; d < 4; ++d) O[d] = zero16();
    lsum = 0.f;
    const f32x16 minit = splat16(negM2);
    __syncthreads();
    __builtin_amdgcn_global_load_lds((const unsigned*)kgs, (lds_ptr_t)(lds + wb), 16, 0, 0);
    __builtin_amdgcn_global_load_lds((const unsigned*)vgs, (lds_ptr_t)(lds + 8192 + wb), 16, 0, 0);
    __builtin_amdgcn_global_load_lds((const unsigned*)(vgs + (size_t)64 * kS), (lds_ptr_t)(lds + 16384 + wb), 16, 0, 0);
    asm volatile("s_waitcnt vmcnt(0)" ::: "memory");
    __syncthreads();
    for (int kt = 0; kt < nkt; ++kt) {
        char* st = lds + (kt & 1) * 24576;
        if (kt + 1 < nkt) {
            char* st2 = lds + ((kt + 1) & 1) * 24576 + wb;
            __builtin_amdgcn_global_load_lds((const unsigned*)(kgs + (size_t)(kt + 1) * 64 * 512), (lds_ptr_t)(st2), 16, 0, 0);
            __builtin_amdgcn_global_load_lds((const unsigned*)(vgs + (kt + 1) * 64), (lds_ptr_t)(st2 + 8192), 16, 0, 0);
            __builtin_amdgcn_global_load_lds((const unsigned*)(vgs + (size_t)64 * kS + (kt + 1) * 64), (lds_ptr_t)(st2 + 16384), 16, 0, 0);
        }
        __builtin_amdgcn_sched_barrier(0);
        if (kt * 64 <= q0 + 31) {
            f32x16 Sx[2];
            {
                bf16x8 kf[2][4];
#pragma unroll
                for (int kb = 0; kb < 2; ++kb)
#pragma unroll
                    for (int ks = 0; ks < 4; ++ks) kf[kb][ks] = *(const bf16x8*)(st + (32 * kb + l31) * 128 + (((2 * ks + h) ^ f) << 4));
                __builtin_amdgcn_sched_barrier(0);
#pragma unroll
                for (int ks = 0; ks < 4; ++ks)
#pragma unroll
                    for (int kb = 0; kb < 2; ++kb) Sx[kb] = ks == 0 ? MFMA(kf[kb][0], qf[0], minit) : MFMA(kf[kb][ks], qf[ks], Sx[kb]);
            }
            if (kt * 64 + 63 > q0) {
#pragma unroll
                for (int kb = 0; kb < 2; ++kb)
#pragma unroll
                    for (int i = 0; i < 16; ++i) {
                        float p = fexp2(Sx[kb][i]);
                        const int key = kt * 64 + 32 * kb + (i & 3) + 8 * (i >> 2) + 4 * h;
                        if (key > qpos) p = 0.f;
                        lsum += p; Sx[kb][i] = p;
                    }
            } else {
                float l0 = 0.f, l1 = 0.f;
#pragma unroll
                for (int i = 0; i < 16; ++i) { const float p0 = fexp2(Sx[0][i]), p1 = fexp2(Sx[1][i]); l0 += p0; l1 += p1; Sx[0][i] = p0; Sx[1][i] = p1; }
                lsum += l0 + l1;
            }
            bf16x8 pf[4];
            pf[0] = pack8(Sx[0], 0); pf[1] = pack8(Sx[0], 1); pf[2] = pack8(Sx[1], 0); pf[3] = pack8(Sx[1], 1);
            {
                bf16x8 vf[2][4];
#pragma unroll
                for (int db = 0; db < 4; ++db) vf[0][db] = *(const bf16x8*)(st + 8192 + (32 * db + l31) * 128 + ((h ^ f) << 4));
#pragma unroll
                for (int s = 0; s < 4; ++s) {
                    if (s < 3) {
#pragma unroll
                        for (int db = 0; db < 4; ++db) vf[(s + 1) & 1][db] = *(const bf16x8*)(st + 8192 + (32 * db + l31) * 128 + (((2 * (s + 1) + h) ^ f) << 4));
                    }
#pragma unroll
                    for (int db = 0; db < 4; ++db) O[db] = MFMA(vf[s & 1][db], pf[s], O[db]);
                    __builtin_amdgcn_sched_barrier(0);
                }
            }
        }
        asm volatile("s_waitcnt vmcnt(0)" ::: "memory");
        __syncthreads();
    }
    lsum += __shfl_xor(lsum, 32);
}

DI void diff_item(const Params& P, int layer, int b, int hd, int qt, float lam, float omli, float negM2, char* lds) {
    const int t = tid(), lane = t & 63, w = t >> 6, h = lane >> 5, l31 = lane & 31;
    const int lr = t >> 3, lc = t & 7;
    bf16_t* dq = slotp(P, SL_DQ); const bf16_t* dk = slotp(P, SL_DK); const bf16_t* dvT = slotp(P, SL_DVT); const bf16_t* dz = slotp(P, SL_DZ);
    const int q0 = qt * 256 + 32 * w;
    const size_t tokq = (size_t)b * kS + q0 + l31;
    const int nkt = (qt + 1) * 4;
    const bf16_t* vg = dvT + ((size_t)(b * 4 + hd) * 128 + lr) * kS + lc * 8;
    u32x4* o0s = (u32x4*)(lds + 49152) + t;
    f32x16 O[4]; float lsum;
#pragma unroll 1
    for (int c = 0; c < 2; ++c) {
        const bf16_t* kg = dk + ((size_t)b * kS + lr) * 512 + hd * 128 + c * 64 + lc * 8;
        diff_pass(dq + tokq * 512 + hd * 128 + c * 64, kg, vg, nkt, q0, negM2, O, lsum, lds);
        if (c == 0) {
            const float inv = frcp(lsum);
#pragma unroll
            for (int db = 0; db < 4; ++db)
#pragma unroll
                for (int i = 0; i < 2; ++i) {
                    u32x4 pkd = {pk2(O[db][8 * i] * inv, O[db][8 * i + 1] * inv), pk2(O[db][8 * i + 2] * inv, O[db][8 * i + 3] * inv),
                                 pk2(O[db][8 * i + 4] * inv, O[db][8 * i + 5] * inv), pk2(O[db][8 * i + 6] * inv, O[db][8 * i + 7] * inv)};
                    o0s[(db * 2 + i) * 512] = pkd;
                }
        }
    }
    const float inv = frcp(lsum) * lam;
    float ss = 0.f;
#pragma unroll
    for (int db = 0; db < 4; ++db) {
#pragma unroll
        for (int i2 = 0; i2 < 2; ++i2) {
            const u32x4 pkd = o0s[(db * 2 + i2) * 512];
#pragma unroll
            for (int j = 0; j < 4; ++j) {
                const int i = 4 * i2 + j;
                const float a = bf_lo(pkd[j]) - O[db][2 * i] * inv, c = bf_hi(pkd[j]) - O[db][2 * i + 1] * inv;
                O[db][2 * i] = a; O[db][2 * i + 1] = c; ss += a * a + c * c;
            }
        }
        __builtin_amdgcn_sched_barrier(0);
    }
    ss += __shfl_xor(ss, 32);
    const float rs = __builtin_amdgcn_rsqf(ss * (1.f / 128.f) + kEps) * omli;
    const float* sw = P.subln + layer * 128;
#pragma unroll
    for (int db = 0; db < 4; ++db) {
#pragma unroll
        for (int q4 = 0; q4 < 4; ++q4) {
            const int dv = 32 * db + 8 * q4 + 4 * h;
            const f32x4 w4 = *(const f32x4*)(sw + dv);
            const u32x2 z2 = *(const u32x2*)(dz + tokq * 512 + hd * 128 + dv);
            const float r0 = O[db][4 * q4] * rs * w4[0] * bf_lo(z2[0]), r1 = O[db][4 * q4 + 1] * rs * w4[1] * bf_hi(z2[0]);
            const float r2 = O[db][4 * q4 + 2] * rs * w4[2] * bf_lo(z2[1]), r3 = O[db][4 * q4 + 3] * rs * w4[3] * bf_hi(z2[1]);
            u32x2 o = {pk2(r0, r1), pk2(r2, r3)};
            *(u32x2*)(dq + tokq * 512 + hd * 128 + dv) = o;
        }
        __builtin_amdgcn_sched_barrier(0);
    }
}

constexpr float kSbExit = -24.f * 1.4426950408889634f;

DI void sb_item(const Params& P, int b, int hd, int qt, char* lds) {
    const int t = tid(), lane = t & 63, w = t >> 6, h = lane >> 5, l31 = lane & 31, f = (lane >> 1) & 7;
    const int lr = t >> 3, lc = t & 7;
    const int wofs = lr * 128 + ((lc ^ ((lr >> 1) & 7)) << 4);
    bf16_t* sq = slotp(P, SL_SQ); const bf16_t* sk = slotp(P, SL_SK); const bf16_t* svT = slotp(P, SL_SVT); const bf16_t* sz = slotp(P, SL_SZ);
    const int q0 = qt * 256 + 32 * w, qpos = q0 + l31;
    const size_t tokq = (size_t)b * kS + qpos;
    volatile int* flags = (volatile int*)(lds + 32768);
    bf16x8 qf[4];
#pragma unroll
    for (int ks = 0; ks < 4; ++ks) qf[ks] = *(const bf16x8*)(sq + tokq * 512 + hd * 64 + 16 * ks + 8 * h);
    f32x16 O[2]; O[0] = zero16(); O[1] = zero16();
    float R = 0.f; bool done = false;
    const bf16_t* kg = sk + ((size_t)b * kS + lr) * 512 + hd * 64 + lc * 8;
    const bf16_t* vg = svT + ((size_t)(b * 8 + hd) * 64 + lr) * kS + lc * 8;
    const int ktop = qt * 4 + 3;
    const int scd = ((lc ^ ((lr >> 1) & 7)) - lc) * 8;
    const bf16_t* kgs = kg + scd; const bf16_t* vgs = vg + scd;
    const int wb = w * 1024;
    __builtin_amdgcn_global_load_lds((const unsigned*)(kgs + (size_t)ktop * 64 * 512), (lds_ptr_t)(lds + wb), 16, 0, 0);
    __builtin_amdgcn_global_load_lds((const unsigned*)(vgs + ktop * 64), (lds_ptr_t)(lds + 8192 + wb), 16, 0, 0);
    asm volatile("s_waitcnt vmcnt(0)" ::: "memory");
    __syncthreads();
    for (int kt = ktop, it = 0; kt >= 0; --kt, ++it) {
        char* st = lds + (it & 1) * 16384;
        const bool more = kt > 0;
        if (more) {
            char* st2 = lds + ((it + 1) & 1) * 16384 + wb;
            __builtin_amdgcn_global_load_lds((const unsigned*)(kgs + (size_t)(kt - 1) * 64 * 512), (lds_ptr_t)(st2), 16, 0, 0);
            __builtin_amdgcn_global_load_lds((const unsigned*)(vgs + (kt - 1) * 64), (lds_ptr_t)(st2 + 8192), 16, 0, 0);
        }
        __builtin_amdgcn_sched_barrier(0);
        if (!done && kt * 64 < q0 + 31) {
            f32x16 Z[2];
#pragma unroll
            for (int kb = 0; kb < 2; ++kb) {
                Z[kb] = zero16();
#pragma unroll
                for (int ks = 0; ks < 4; ++ks) {
                    const bf16x8 kf = *(const bf16x8*)(st + (32 * kb + l31) * 128 + (((2 * ks + h) ^ f) << 4));
                    Z[kb] = MFMA(kf, qf[ks], Z[kb]);
                }
            }
            const bool diag = kt * 64 + 63 >= q0;
            float run = R;
#pragma unroll
            for (int kb = 1; kb >= 0; --kb) {
                float Lv[16];
                if (diag) {
#pragma unroll
                    for (int i = 0; i < 16; ++i) {
                        const float z = Z[kb][i];
                        const float sp = fmaxf(z, 0.f) + flog2(1.f + fexp2(-fabsf(z)));
                        const int key = kt * 64 + 32 * kb + (i & 3) + 8 * (i >> 2) + 4 * h;
                        const bool past = key < qpos;
                        Lv[i] = past ? -sp : 0.f;
                        Z[kb][i] = past ? z : -1e30f;
                    }
                } else {
#pragma unroll
                    for (int i = 0; i < 16; ++i) {
                        const float z = Z[kb][i];
                        Lv[i] = -(fmaxf(z, 0.f) + flog2(1.f + fexp2(-fabsf(z))));
                    }
                }
                float cs[4], ps[4];
#pragma unroll
                for (int g = 0; g < 4; ++g) { cs[g] = (Lv[4 * g] + Lv[4 * g + 1]) + (Lv[4 * g + 2] + Lv[4 * g + 3]); ps[g] = __shfl_xor(cs[g], 32); }
#pragma unroll
                for (int g = 3; g >= 0; --g) {
                    const float off = run + (h == 0 ? ps[g] : 0.f);
                    const float l3 = off, l2 = l3 + Lv[4 * g + 3], l1 = l2 + Lv[4 * g + 2], l0 = l1 + Lv[4 * g + 1];
                    Z[kb][4 * g + 3] = fexp2(Z[kb][4 * g + 3] + Lv[4 * g + 3] + l3);
                    Z[kb][4 * g + 2] = fexp2(Z[kb][4 * g + 2] + Lv[4 * g + 2] + l2);
                    Z[kb][4 * g + 1] = fexp2(Z[kb][4 * g + 1] + Lv[4 * g + 1] + l1);
                    Z[kb][4 * g + 0] = fexp2(Z[kb][4 * g + 0] + Lv[4 * g + 0] + l0);
                    run += cs[g] + ps[g];
                }
            }
            R = run;
            bf16x8 pf[4];
            pf[0] = pack8(Z[0], 0); pf[1] = pack8(Z[0], 1); pf[2] = pack8(Z[1], 0); pf[3] = pack8(Z[1], 1);
#pragma unroll
            for (int s = 0; s < 4; ++s)
#pragma unroll
                for (int db = 0; db < 2; ++db) {
                    const bf16x8 vf = *(const bf16x8*)(st + 8192 + (32 * db + l31) * 128 + (((2 * s + h) ^ f) << 4));
                    O[db] = MFMA(vf, pf[s], O[db]);
                }
            done = __all(R < kSbExit) != 0;
        }
        if (lane == 0) flags[(it & 1) * 8 + w] = done ? 1 : 0;
        asm volatile("s_waitcnt vmcnt(0)" ::: "memory");
        __syncthreads();
        int alld = 1;
#pragma unroll
        for (int i = 0; i < 8; ++i) alld &= flags[(it & 1) * 8 + i];
        if (alld) break;
    }
#pragma unroll
    for (int db = 0; db < 2; ++db)
#pragma unroll
        for (int q4 = 0; q4 < 4; ++q4) {
            const int dv = 32 * db + 8 * q4 + 4 * h;
            const u32x2 z2 = *(const u32x2*)(sz + tokq * 512 + hd * 64 + dv);
            u32x2 o = {pk2(O[db][4 * q4] * bf_lo(z2[0]), O[db][4 * q4 + 1] * bf_hi(z2[0])), pk2(O[db][4 * q4 + 2] * bf_lo(z2[1]), O[db][4 * q4 + 3] * bf_hi(z2[1]))};
            *(u32x2*)(sq + tokq * 512 + hd * 64 + dv) = o;
        }
    __syncthreads();
}

DI void attn_phase(const Params& P, int layer, char* lds) {
    conv_pass(P, layer);
    const int lane = tid() & 63;
    float a1 = P.lq1[layer * 64 + lane] * P.lk1[layer * 64 + lane], a2 = P.lq2[layer * 64 + lane] * P.lk2[layer * 64 + lane];
    float mq = fabsf(P.dqn[layer * 64 + lane]), mk = fabsf(P.dkn[layer * 64 + lane]);
#pragma unroll
    for (int o = 32; o >= 1; o >>= 1) { a1 += __shfl_xor(a1, o); a2 += __shfl_xor(a2, o); mq = fmaxf(mq, __shfl_xor(mq, o)); mk = fmaxf(mk, __shfl_xor(mk, o)); }
    const float lam_init = 0.8f - 0.6f * __expf(-0.3f * (float)layer);
    const float lam = __expf(a1) - __expf(a2) + lam_init;
    const float negM2 = -(8.f * mq * mk * kLog2e);
    for (int i = blockIdx.x; i < 256; i += gridDim.x) {
        const int x = i & 7, j = i >> 3, bh = x * 2 + (j >> 4), pr = j & 15;
#pragma unroll 1
        for (int e = 0; e < 2; ++e) diff_item(P, layer, bh >> 2, bh & 3, e ? pr : 31 - pr, lam, 1.f - lam_init, negM2, lds);
    }
    for (int i = blockIdx.x; i < 1024; i += gridDim.x) {
        const int x = i & 7, j = i >> 3, bh = x * 4 + (j >> 5), qt = j & 31;
        sb_item(P, bh >> 3, bh & 7, qt, lds);
    }
}

DI unsigned q8(float g) { return (unsigned)(g * 255.f + 0.5f); }
DI unsigned q8f(float g) { const unsigned q = (unsigned)(g * 255.f + 0.5f); return q > 1u ? q : 1u; }
DI unsigned q8fx4(float a, float b, float c, float d) { return q8f(a) | (q8f(b) << 8) | (q8f(c) << 16) | (q8f(d) << 24); }
DI unsigned q8x4(float a, float b, float c, float d) { return q8(a) | (q8(b) << 8) | (q8(c) << 16) | (q8(d) << 24); }
DI float dq8(unsigned w, int k) { return (float)((w >> (8 * k)) & 255u) * (1.f / 255.f); }
DI u32x4* gate_slot(const Params& P, int tile, int j, int g8) { return (u32x4*)slotp(P, SL_SK) + ((size_t)(tile * 3 + j) * 8 + g8) * 512 + tid(); }

DI void gate_epilogue(const Params& P, int layer, int j, const f32x4 (&acc)[2][2][4][2], int tile, int n0, const char* lds) {
    LANE_DECODE; (void)lane;
    const float* rsl = (const float*)(lds + LDS_RS);
#pragma unroll
    for (int ai = 0; ai < 2; ++ai) {
        const int col = n0 + ai * 128 + wr * 64 + 8 * fq;
        const float* bg = P.b_gate + layer * 3072 + j * 1024 + col;
        const f32x4 b0 = *(const f32x4*)bg, b1 = *(const f32x4*)(bg + 4), b2 = *(const f32x4*)(bg + 32), b3 = *(const f32x4*)(bg + 36);
#pragma unroll
        for (int bj = 0; bj < 2; ++bj)
#pragma unroll
            for (int nn = 0; nn < 2; ++nn) {
                const int rl = bj * 128 + wc * 32 + nn * 16 + fr;
                float lo[8], hi[8];
                grp16(acc, ai, bj, nn, rsl[rl], lo, hi);
#pragma unroll
                for (int i = 0; i < 4; ++i) { lo[i] = sigm(lo[i] + b0[i]); lo[4 + i] = sigm(lo[4 + i] + b1[i]); hi[i] = sigm(hi[i] + b2[i]); hi[4 + i] = sigm(hi[4 + i] + b3[i]); }
                u32x4 o = {q8fx4(lo[0], lo[1], lo[2], lo[3]), q8fx4(lo[4], lo[5], lo[6], lo[7]), q8fx4(hi[0], hi[1], hi[2], hi[3]), q8fx4(hi[4], hi[5], hi[6], hi[7])};
                *gate_slot(P, tile, j, ai * 4 + bj * 2 + nn) = o;
                __builtin_amdgcn_sched_barrier(0);
            }
    }
}

DI void merge_scale(const Params& P, int tile, int seg, f32x4 (&acc)[2][2][4][2]) {
#pragma unroll
    for (int g8 = 0; g8 < 8; ++g8) {
        const int ai = g8 >> 2, bj = (g8 >> 1) & 1, nn = g8 & 1;
        const u32x4 ga = *gate_slot(P, tile, seg, g8), gb = *gate_slot(P, tile, seg + 1, g8);
#pragma unroll
        for (int e = 0; e < 8; ++e) {
            const float rl = (float)((ga[e >> 2] >> (8 * (e & 3))) & 255u) * frcp((float)((gb[e >> 2] >> (8 * (e & 3))) & 255u));
            const float rh = (float)((ga[2 + (e >> 2)] >> (8 * (e & 3))) & 255u) * frcp((float)((gb[2 + (e >> 2)] >> (8 * (e & 3))) & 255u));
            acc[ai][bj][e >> 2][nn][e & 3] *= rl;
            acc[ai][bj][2 + (e >> 2)][nn][e & 3] *= rh;
        }
        __builtin_amdgcn_sched_barrier(0);
    }
}

DI void merge_final(const Params& P, int tile, bf16_t* __restrict__ hb, const f32x4 (&acc)[2][2][4][2], int m0, int n0) {
    LANE_DECODE; (void)lane;
#pragma unroll
    for (int ai = 0; ai < 2; ++ai)
#pragma unroll
        for (int bj = 0; bj < 2; ++bj)
#pragma unroll
            for (int nn = 0; nn < 2; ++nn) {
                const size_t tok = (size_t)m0 + bj * 128 + wc * 32 + nn * 16 + fr;
                const int col = n0 + ai * 128 + wr * 64 + 8 * fq;
                float lo[8], hi[8];
                grp16(acc, ai, bj, nn, 1.f, lo, hi);
                const u32x4 gq = *gate_slot(P, tile, 2, ai * 4 + bj * 2 + nn);
#pragma unroll
                for (int e = 0; e < 8; ++e) { lo[e] *= dq8(gq[e >> 2], e & 3); hi[e] *= dq8(gq[2 + (e >> 2)], e & 3); }
                bf16_t* hp = hb + tok * 1024 + col;
                st8(hp, lo); st8(hp + 32, hi);
                __builtin_amdgcn_sched_barrier(0);
            }
}

DI void merge_phase(const Params& P, int layer, char* lds) {
    const bf16_t* xb = (const bf16_t*)(P.ws + ((layer & 1) ? OFF_HB : OFF_XN));
    bf16_t* hb = (bf16_t*)(P.ws + ((layer & 1) ? OFF_XN : OFF_HB));
    const float* ssq = (const float*)(P.ws + OFF_SSQA);
    for (int t = blockIdx.x; t < 128 * 4; t += gridDim.x) {
        int mt, nt; tile_map(t, mt, nt);
        const int m0 = mt * 256, n0 = nt * 256;
        tile_rstd(ssq, m0, lds);
        f32x4 acc[2][2][4][2];
#pragma unroll 1
        for (int j = 0; j < 3; ++j) {
            gemm8(acc, wtp(P, layer, W_G) + (size_t)(j * 1024 + n0) * 1024, xb + (size_t)m0 * 1024, 1024, lds);
            __syncthreads();
            gate_epilogue(P, layer, j, acc, t, n0, lds);
        }
        gemm8_cat3(acc, wtp(P, layer, W_OC) + (size_t)n0 * 512, wtp(P, layer, W_OSB) + (size_t)n0 * 512, wtp(P, layer, W_OD) + (size_t)n0 * 512,
                   slotp(P, SL_BZ) + (size_t)m0 * 512, slotp(P, SL_SQ) + (size_t)m0 * 512, slotp(P, SL_DQ) + (size_t)m0 * 512, lds,
                   [&](int seg) { merge_scale(P, t, seg, acc); });
        merge_final(P, t, hb, acc, m0, n0);
    }
    p_to_bf16(P.p + (size_t)layer * kT * 256, slotp(P, SL_CU));
}

template <bool XBF, bool WF32>
DI void resid_epilogue(const float* __restrict__ xs, const bf16_t* __restrict__ xsb, float* __restrict__ out, bf16_t* __restrict__ xbn, float* __restrict__ ssq,
                       const f32x4 (&acc)[2][2][4][2], int m0, int n0, int nt, bool wxb = true) {
    LANE_DECODE; (void)lane;
#pragma unroll
    for (int bj = 0; bj < 2; ++bj)
#pragma unroll
        for (int nn = 0; nn < 2; ++nn) {
            const size_t tok = (size_t)m0 + bj * 128 + wc * 32 + nn * 16 + fr;
            float ss = 0.f;
#pragma unroll
            for (int ai = 0; ai < 2; ++ai) {
                float lo[8], hi[8];
                grp16(acc, ai, bj, nn, 1.f, lo, hi);
                const size_t o = tok * 1024 + n0 + ai * 128 + wr * 64 + 8 * fq;
                if (XBF) {
                    const u32x4 xl = *(const u32x4*)(xsb + o), xh = *(const u32x4*)(xsb + o + 32);
#pragma unroll
                    for (int j = 0; j < 4; ++j) { lo[2 * j] += bf_lo(xl[j]); lo[2 * j + 1] += bf_hi(xl[j]); hi[2 * j] += bf_lo(xh[j]); hi[2 * j + 1] += bf_hi(xh[j]); }
                } else {
#pragma unroll
                    for (int q4 = 0; q4 < 2; ++q4) {
                        const f32x4 xl = *(const f32x4*)(xs + o + 4 * q4), xh = *(const f32x4*)(xs + o + 32 + 4 * q4);
#pragma unroll
                        for (int j = 0; j < 4; ++j) { lo[4 * q4 + j] += xl[j]; hi[4 * q4 + j] += xh[j]; }
                    }
                }
#pragma unroll
                for (int i = 0; i < 8; ++i) ss += lo[i] * lo[i] + hi[i] * hi[i];
                if (WF32) {
#pragma unroll
                    for (int q4 = 0; q4 < 2; ++q4) {
                        *(f32x4*)(out + o + 4 * q4) = (f32x4){lo[4 * q4], lo[4 * q4 + 1], lo[4 * q4 + 2], lo[4 * q4 + 3]};
                        *(f32x4*)(out + o + 32 + 4 * q4) = (f32x4){hi[4 * q4], hi[4 * q4 + 1], hi[4 * q4 + 2], hi[4 * q4 + 3]};
                    }
                }
                if (wxb) { st8(xbn + o, lo); st8(xbn + o + 32, hi); }
            }
            ss += __shfl_xor(ss, 16); ss += __shfl_xor(ss, 32);
            if (wxb && fq < 2) ssq[tok * 16 + 4 * nt + 2 * fq + wr] = fq == 0 ? ss : 0.f;
            __builtin_amdgcn_sched_barrier(0);
        }
}

DI void wout_phase(const Params& P, int layer, char* lds) {
    const bf16_t* hb = (const bf16_t*)(P.ws + ((layer & 1) ? OFF_XN : OFF_HB));
    bf16_t* xb2 = (bf16_t*)(P.ws + ((layer & 1) ? OFF_HB : OFF_XN));
    const float* xs = layer == 0 ? P.x : P.out;
    for (int t = blockIdx.x; t < 128 * 4; t += gridDim.x) {
        int mt, nt; tile_map(t, mt, nt);
        const int m0 = mt * 256, n0 = nt * 256;
        f32x4 acc[2][2][4][2];
        gemm8(acc, wtp(P, layer, W_OUT) + (size_t)n0 * 1024, hb + (size_t)m0 * 1024, 1024, lds);
        resid_epilogue<false, false>(xs, nullptr, nullptr, xb2, (float*)(P.ws + OFF_SSQB), acc, m0, n0, nt);
    }
}

DI u32x4* ple_slot(const Params& P, int tile, int g8) { return (u32x4*)slotp(P, SL_SQ) + ((size_t)tile * 8 + g8) * 512 + tid(); }

DI void ple_gate_store(const Params& P, const f32x4 (&acc)[2][2][4][2], int tile, const char* lds) {
    LANE_DECODE; (void)lane; (void)wr; (void)fq;
    const float* rsl = (const float*)(lds + LDS_RS);
#pragma unroll
    for (int ai = 0; ai < 2; ++ai)
#pragma unroll
        for (int bj = 0; bj < 2; ++bj)
#pragma unroll
            for (int nn = 0; nn < 2; ++nn) {
                float lo[8], hi[8];
                grp16(acc, ai, bj, nn, rsl[bj * 128 + wc * 32 + nn * 16 + fr], lo, hi);
#pragma unroll
                for (int i = 0; i < 8; ++i) { lo[i] = sigm(lo[i]); hi[i] = sigm(hi[i]); }
                u32x4 o = {q8x4(lo[0], lo[1], lo[2], lo[3]), q8x4(lo[4], lo[5], lo[6], lo[7]), q8x4(hi[0], hi[1], hi[2], hi[3]), q8x4(hi[4], hi[5], hi[6], hi[7])};
                *ple_slot(P, tile, ai * 4 + bj * 2 + nn) = o;
                __builtin_amdgcn_sched_barrier(0);
            }
}

DI void ple_gate_apply(const Params& P, f32x4 (&acc)[2][2][4][2], int tile) {
#pragma unroll
    for (int ai = 0; ai < 2; ++ai)
#pragma unroll
        for (int bj = 0; bj < 2; ++bj)
#pragma unroll
            for (int nn = 0; nn < 2; ++nn) {
                const u32x4 gq = *ple_slot(P, tile, ai * 4 + bj * 2 + nn);
#pragma unroll
                for (int e = 0; e < 8; ++e) {
                    acc[ai][bj][e >> 2][nn][e & 3] *= dq8(gq[e >> 2], e & 3);
                    acc[ai][bj][2 + (e >> 2)][nn][e & 3] *= dq8(gq[2 + (e >> 2)], e & 3);
                }
                __builtin_amdgcn_sched_barrier(0);
            }
}

DI void ple_phase(const Params& P, int layer, char* lds) {
    const bf16_t* xb2 = (const bf16_t*)(P.ws + ((layer & 1) ? OFF_HB : OFF_XN));
    bf16_t* xb3 = (bf16_t*)(P.ws + ((layer & 1) ? OFF_XN : OFF_HB));
    const bf16_t* pb = slotp(P, SL_CU);
    for (int t = blockIdx.x; t < 128 * 4; t += gridDim.x) {
        int mt, nt; tile_map(t, mt, nt);
        const int m0 = mt * 256, n0 = nt * 256;
        tile_rstd((const float*)(P.ws + OFF_SSQB), m0, lds);
        f32x4 acc[2][2][4][2];
        gemm8(acc, wtp(P, layer, W_PG) + (size_t)n0 * 1024, xb2 + (size_t)m0 * 1024, 1024, lds);
        __syncthreads();
        ple_gate_store(P, acc, t, lds);
        gemm8(acc, wtp(P, layer, W_PLE) + (size_t)n0 * 256, pb + (size_t)m0 * 256, 256, lds);
        ple_gate_apply(P, acc, t);
        resid_epilogue<true, true>(nullptr, xb2, P.out, xb3, (float*)(P.ws + OFF_SSQA), acc, m0, n0, nt, layer == 0);
    }
}

DI void prologue_phase(const Params& P, char* lds) {
    for (int l = 0; l < 2; ++l) {
        convert_job(P.w_in + (size_t)l * 1024 * 9216, 9216, 1024, 6144, 1, 0, P.norm_w + l * 1024, wtp(P, l, W_IN), lds);
        convert_job(P.w_in + (size_t)l * 1024 * 9216, 9216, 1024, 3072, 0, 6144, P.norm_w + l * 1024, wtp(P, l, W_G), lds);
        convert_job(P.w_oc + (size_t)l * 512 * 1024, 1024, 512, 1024, 0, 0, nullptr, wtp(P, l, W_OC), lds);
        convert_job(P.w_osb + (size_t)l * 512 * 1024, 1024, 512, 1024, 0, 0, nullptr, wtp(P, l, W_OSB), lds);
        convert_job(P.w_od + (size_t)l * 512 * 1024, 1024, 512, 1024, 0, 0, nullptr, wtp(P, l, W_OD), lds);
        convert_job(P.w_out + (size_t)l * 1024 * 1024, 1024, 1024, 1024, 0, 0, nullptr, wtp(P, l, W_OUT), lds);
        convert_job(P.w_pg + (size_t)l * 1024 * 1024, 1024, 1024, 1024, 0, 0, P.ple_norm + l * 1024, wtp(P, l, W_PG), lds);
        convert_job(P.w_ple + (size_t)l * 256 * 1024, 1024, 256, 1024, 0, 0, nullptr, wtp(P, l, W_PLE), lds);
    }
    rope_tables(P);
    x_to_bf16_ssq(P.x, (bf16_t*)(P.ws + OFF_XN), (float*)(P.ws + OFF_SSQA));
}

constexpr int kNumPhases = 11;
DI void run_phase(const Params& P, int ph, char* lds) {
    if (ph == 0) { prologue_phase(P, lds); return; }
    const int layer = (ph - 1) / 5, s = (ph - 1) % 5;
    switch (s) {
        case 0: inproj_phase(P, layer, lds); break;
        case 1: attn_phase(P, layer, lds); break;
        case 2: merge_phase(P, layer, lds); break;
        case 3: wout_phase(P, layer, lds); break;
        default: ple_phase(P, layer, lds); break;
    }
}


#define XB_TMO      128
#define XB_XCNT(j)  (256  + 64 * (j))
#define XB_XSUB(j)  (1280 + 64 * (j))
#define XB_XGEN(j)  (2304 + 64 * (j))
#define XB_TOP      3328
#define XB_TOPGEN   3392
#define XCD_BAR_WORDS 3456
#define XB_SPIN_CAP (1u << 22)
#define LAS __attribute__((address_space(3)))
DI unsigned xb_ld(unsigned* p) { return __hip_atomic_load(p, __ATOMIC_RELAXED, __HIP_MEMORY_SCOPE_AGENT); }
DI unsigned xb_add(unsigned* p, unsigned v) { return __hip_atomic_fetch_add(p, v, __ATOMIC_RELAXED, __HIP_MEMORY_SCOPE_AGENT); }
DI unsigned xb_xcc_id() { return (unsigned)__builtin_amdgcn_s_getreg((3 << 11) | 20) & 0xFu; }
#define XB_SPIN(cond, bar) do { unsigned _sp = 0; while (cond) { __builtin_amdgcn_s_sleep(1); \
    if ((++_sp & 255u) == 0u) { if (xb_ld(&(bar)[XB_TMO])) break; if (_sp > XB_SPIN_CAP) { atomicAdd(&(bar)[XB_TMO], 1u); break; } } } } while (0)
struct XcdBarrier { unsigned* bar; unsigned x; volatile LAS unsigned* st; };
DI XcdBarrier xcd_barrier_post(unsigned* bar, volatile LAS unsigned* st) {
    XcdBarrier b; b.bar = bar; b.x = xb_xcc_id(); b.st = st;
    if (threadIdx.x == 0) (void)xb_add(&bar[XB_XCNT(b.x)], 1u);
    return b;
}
DI void xcd_barrier_complete(unsigned* bar, unsigned x, unsigned& nloc, unsigned& nx) {
    const unsigned G = gridDim.x * gridDim.y * gridDim.z;
    unsigned sum, cnt, mine, sp = 0u;
    for (;;) {
        sum = 0u; cnt = 0u; mine = 0u;
#pragma unroll
        for (unsigned j = 0; j < 16; ++j) { const unsigned c = xb_ld(&bar[XB_XCNT(j)]); sum += c; cnt += (c > 0u) ? 1u : 0u; mine = (j == x) ? c : mine; }
        if (sum == G) break;
        __builtin_amdgcn_s_sleep(1);
        if ((++sp & 255u) == 0u) { if (xb_ld(&bar[XB_TMO])) break; if (sp > XB_SPIN_CAP) { atomicAdd(&bar[XB_TMO], 1u); break; } }
    }
    nloc = mine > 0u ? mine : 1u; nx = cnt > 0u ? cnt : 1u;
}
DI void xcd_barrier(const XcdBarrier& b) {
    asm volatile("s_waitcnt vmcnt(0)" ::: "memory");
    __syncthreads();
    if (threadIdx.x == 0) {
        unsigned* bar = b.bar;
        __builtin_amdgcn_s_waitcnt(0);
        unsigned nloc = b.st[0], nx = b.st[1];
        if (nloc == 0u) { xcd_barrier_complete(bar, b.x, nloc, nx); b.st[0] = nloc; b.st[1] = nx; }
        const unsigned old = xb_add(&bar[XB_XSUB(b.x)], 1u);
        const unsigned gen = old / nloc;
        if (old + 1u == (gen + 1u) * nloc) {
            __builtin_amdgcn_fence(__ATOMIC_RELEASE, "agent");
            asm volatile("s_waitcnt vmcnt(0)" ::: "memory");
            const unsigned og = xb_add(&bar[XB_TOP], 1u);
            const unsigned tg = og / nx;
            if (og + 1u == (tg + 1u) * nx) xb_add(&bar[XB_TOPGEN], 1u);
            else XB_SPIN(xb_ld(&bar[XB_TOPGEN]) == tg, bar);
            __builtin_amdgcn_fence(__ATOMIC_ACQUIRE, "agent");
            xb_add(&bar[XB_XGEN(b.x)], 1u);
            asm volatile("s_waitcnt vmcnt(0)" ::: "memory");
        } else {
            XB_SPIN(xb_ld(&bar[XB_XGEN(b.x)]) == gen, bar);
            __builtin_amdgcn_fence(__ATOMIC_ACQUIRE, "agent");
            asm volatile("s_waitcnt vmcnt(0)" ::: "memory");
        }
    }
    __syncthreads();
}

__global__ void __launch_bounds__(512) fwd_megakernel(Params P) {
    __shared__ __attribute__((aligned(16))) char smem[LDS_BYTES];
    unsigned* bar = (unsigned*)(P.ws + OFF_BAR);
    volatile LAS unsigned* xst = (volatile LAS unsigned*)(smem + LDS_XB);
    if (threadIdx.x < 4) xst[threadIdx.x] = 0u;
    if (blockIdx.x == 0) for (int i = threadIdx.x; i < XCD_BAR_WORDS; i += 512) bar[i] = 0u;
    __syncthreads();
    for (int ph = P.ph_lo; ph < P.ph_hi; ++ph) {
        run_phase(P, ph, smem);
        if (ph + 1 < P.ph_hi) {
            if (ph == P.ph_lo) { cg::this_grid().sync(); (void)xcd_barrier_post((unsigned*)(P.ws + OFF_BAR), (volatile LAS unsigned*)(smem + LDS_XB)); }
            else { XcdBarrier xb; xb.bar = (unsigned*)(P.ws + OFF_BAR); xb.x = xb_xcc_id(); xb.st = (volatile LAS unsigned*)(smem + LDS_XB); xcd_barrier(xb); }
        }
    }
}

extern "C" void kernel_launch(void* const* d_in, const int* in_sizes, int n_in, void* d_out, int out_size, void* d_ws, size_t ws_size,
                              hipStream_t stream) {
    if (ws_size < WS_NEED) { fprintf(stderr, "workspace too small: %zu < %zu\n", ws_size, (size_t)WS_NEED); return; }
    Params P{};
    P.x = (const float*)d_in[0]; P.p = (const float*)d_in[1]; P.norm_w = (const float*)d_in[2]; P.w_in = (const float*)d_in[3];
    P.b_gate = (const float*)d_in[4]; P.conv_w = (const float*)d_in[5]; P.dqn = (const float*)d_in[6]; P.dkn = (const float*)d_in[7];
    P.lq1 = (const float*)d_in[8]; P.lk1 = (const float*)d_in[9]; P.lq2 = (const float*)d_in[10]; P.lk2 = (const float*)d_in[11];
    P.subln = (const float*)d_in[12]; P.w_oc = (const float*)d_in[13]; P.w_osb = (const float*)d_in[14]; P.w_od = (const float*)d_in[15];
    P.w_out = (const float*)d_in[16]; P.ple_norm = (const float*)d_in[17]; P.w_pg = (const float*)d_in[18]; P.w_ple = (const float*)d_in[19];
    P.out = (float*)d_out; P.ws = (char*)d_ws;
#if MK_MULTI
    for (int ph = 0; ph < kNumPhases; ++ph) {
        P.ph_lo = ph; P.ph_hi = ph + 1;
        hipLaunchKernelGGL(fwd_megakernel, dim3(256), dim3(512), 0, stream, P);
    }
#else
    static int grid_blocks = 0;
    if (!grid_blocks) {
        int dev = 0, cus = 0, per_cu = 0;
        (void)hipGetDevice(&dev);
        (void)hipDeviceGetAttribute(&cus, hipDeviceAttributeMultiprocessorCount, dev);
        (void)hipOccupancyMaxActiveBlocksPerMultiprocessor(&per_cu, fwd_megakernel, 512, 0);
        if (per_cu < 1) per_cu = 1;
        if (per_cu > 1) per_cu = 1;
        grid_blocks = cus * per_cu;
    }
    P.ph_lo = 0; P.ph_hi = kNumPhases;
    void* args[] = {&P};
    hipError_t e = hipLaunchCooperativeKernel((void*)fwd_megakernel, dim3(grid_blocks), dim3(512), args, 0, stream);
    if (e != hipSuccess) fprintf(stderr, "cooperative launch failed: %s (grid %d)\n", hipGetErrorString(e), grid_blocks);
#endif
}
```

```cpp
#include <hip/hip_runtime.h>
#include <hip/hip_cooperative_groups.h>
#include <cstdio>
#include <cstdint>
namespace cg = cooperative_groups;

#ifndef MK_MULTI
#define MK_MULTI 0
#endif
#ifndef PROBE_DUP
#define PROBE_DUP -1
#endif

typedef unsigned short bf16_t;
typedef short bf16x8 __attribute__((ext_vector_type(8)));
typedef float f32x16 __attribute__((ext_vector_type(16)));
typedef float f32x4 __attribute__((ext_vector_type(4)));
typedef float f32x2 __attribute__((ext_vector_type(2)));
typedef unsigned u32x4 __attribute__((ext_vector_type(4)));
typedef unsigned u32x2 __attribute__((ext_vector_type(2)));
typedef __bf16 bf2_t __attribute__((ext_vector_type(2)));
#define DI __device__ __forceinline__
#define MFMA(a, b, c) __builtin_amdgcn_mfma_f32_32x32x16_bf16((a), (b), (c), 0, 0, 0)

constexpr int kB = 4, kS = 8192, kT = kB * kS;
constexpr float kEps = 1e-6f;
constexpr float kLog2e = 1.4426950408889634f;
constexpr float kLn2 = 0.6931471805599453f;
constexpr size_t MiB = 1u << 20;
constexpr size_t OFF_COS = 0, OFF_SIN = 1 * MiB, OFF_WT = 4 * MiB, OFF_XN = 56 * MiB, OFF_HB = 120 * MiB, OFF_PROJ = 184 * MiB;
constexpr size_t PROJ_SLOT = 32 * MiB;
constexpr size_t OFF_SSQA = 2 * MiB, OFF_SSQB = 504 * MiB, OFF_BAR = 506 * MiB;
constexpr size_t WS_NEED = 507 * MiB;
enum { SL_CU = 0, SL_BZ = 1, SL_SQ = 2, SL_DQ = 3, SL_SK = 4, SL_SVT = 5, SL_SZ = 6, SL_DK = 7, SL_DVT = 8, SL_DZ = 9 };
constexpr int LDS_RS = 131072;
constexpr size_t W_IN = 0, W_G = W_IN + 6144 * 1024, W_OC = W_G + 3072 * 1024, W_OSB = W_OC + 512 * 1024, W_OD = W_OSB + 512 * 1024,
                 W_OUT = W_OD + 512 * 1024, W_PG = W_OUT + 1024 * 1024, W_PLE = W_PG + 1024 * 1024, W_LAYER = W_PLE + 256 * 1024;
constexpr int LDS_XB = 132096;
constexpr int LDS_BYTES = 133120;

struct Params {
    const float* x; const float* p; const float* norm_w; const float* w_in; const float* b_gate; const float* conv_w;
    const float* dqn; const float* dkn; const float* lq1; const float* lk1; const float* lq2; const float* lk2;
    const float* subln; const float* w_oc; const float* w_osb; const float* w_od; const float* w_out; const float* ple_norm;
    const float* w_pg; const float* w_ple;
    float* out; char* ws;
    int ph_lo, ph_hi;
};

DI int tid() { int t = __builtin_amdgcn_workitem_id_x(); asm volatile("" : "+v"(t)); return t; }
DI unsigned pk2(float a, float b) { f32x2 v = {a, b}; return __builtin_bit_cast(unsigned, __builtin_convertvector(v, bf2_t)); }
DI float bf_lo(unsigned u) { return __uint_as_float(u << 16); }
DI float bf_hi(unsigned u) { return __uint_as_float(u & 0xffff0000u); }
DI float fexp2(float x) { return __builtin_amdgcn_exp2f(x); }
DI float flog2(float x) { return __builtin_amdgcn_logf(x); }
DI float frcp(float x) { return __builtin_amdgcn_rcpf(x); }
DI float sigm(float x) { return frcp(1.f + fexp2(-kLog2e * x)); }
DI float silu(float x) { return x * sigm(x); }
DI bf16_t* slotp(const Params& P, int s) { return (bf16_t*)(P.ws + OFF_PROJ + (size_t)s * PROJ_SLOT); }
DI bf16_t* wtp(const Params& P, int layer, size_t off) { return (bf16_t*)(P.ws + OFF_WT) + (size_t)layer * W_LAYER + off; }

DI void st16(bf16_t* dst, const f32x16& v) {
    u32x4 a = {pk2(v[0], v[1]), pk2(v[2], v[3]), pk2(v[4], v[5]), pk2(v[6], v[7])};
    u32x4 b = {pk2(v[8], v[9]), pk2(v[10], v[11]), pk2(v[12], v[13]), pk2(v[14], v[15])};
    *(u32x4*)dst = a; *(u32x4*)(dst + 8) = b;
}
DI f32x16 zero16() { f32x16 z; for (int i = 0; i < 16; ++i) z[i] = 0.f; return z; }
DI f32x16 splat16(float v) { f32x16 z; for (int i = 0; i < 16; ++i) z[i] = v; return z; }

typedef __attribute__((address_space(3))) void* lds_ptr_t;
#define MFMA16(a, b, c) __builtin_amdgcn_mfma_f32_16x16x32_bf16((a), (b), (c), 0, 0, 0)
DI int lds_byte(int r, int c) { const int st = (r >> 4) * 2 + (c >> 5), rr = r & 15, cc = c & 31, ob = rr * 64 + cc * 2; return st * 1024 + (ob ^ (((ob >> 9) & 1) << 5)); }
DI void stage_rc(int b, int& R, int& C) { const int st = b / 1024, sb = b % 1024, swz = sb ^ (((sb >> 9) & 1) << 5); R = (st >> 1) * 16 + swz / 64; C = (st & 1) * 32 + (swz % 64) / 2; }

DI void gemm8(f32x4 (&acc)[2][2][4][2], const bf16_t* __restrict__ Rm, const bf16_t* __restrict__ Cm, int K, char* shm) {
    constexpr int HT2 = 128 * 64 * 2;
    const int t = tid(), wid = t >> 6, lane = t & 63, wr = wid >> 2, wc = wid & 3, fr = lane & 15, fq = lane >> 4;
#define SA(b, hh) (shm + ((b) * 2 + (hh)) * HT2)
#define SB(b, hh) (shm + (4 + (b) * 2 + (hh)) * HT2)
    int gofs[2];
#pragma unroll
    for (int i = 0; i < 2; ++i) { int r_, c_; stage_rc(t * 16 + i * 8192, r_, c_); gofs[i] = r_ * K + c_; }
    const int wb = wid * 1024;
#define STAGE(P, BASE, br, kt) do { const bf16_t* g_ = (BASE) + (size_t)(br) * K + (size_t)(kt) * 64; \
        _Pragma("unroll") for (int i_ = 0; i_ < 2; ++i_) \
            __builtin_amdgcn_global_load_lds((const unsigned*)(g_ + gofs[i_]), (lds_ptr_t)((P) + wb + i_ * 8192), 16, 0, 0); } while (0)
#define LDA(dst, b, hh) _Pragma("unroll") for (int m = 0; m < 4; ++m) _Pragma("unroll") for (int k = 0; k < 2; ++k) \
        dst[m][k] = *(const bf16x8*)(SA(b, hh) + lds_byte(wr * 64 + m * 16 + fr, k * 32 + fq * 8))
#define LDB(dst, b, hh) _Pragma("unroll") for (int n = 0; n < 2; ++n) _Pragma("unroll") for (int k = 0; k < 2; ++k) \
        dst[n][k] = *(const bf16x8*)(SB(b, hh) + lds_byte(wc * 32 + n * 16 + fr, k * 32 + fq * 8))
#define MMA(ai, bj, At_, Bt_) do { __builtin_amdgcn_s_setprio(1); \
        _Pragma("unroll") for (int m = 0; m < 4; ++m) _Pragma("unroll") for (int n = 0; n < 2; ++n) _Pragma("unroll") for (int k = 0; k < 2; ++k) \
            acc[ai][bj][m][n] = MFMA16(At_[m][k], Bt_[n][k], acc[ai][bj][m][n]); \
        __builtin_amdgcn_s_setprio(0); } while (0)
#define WAIT_V(n) asm volatile("s_waitcnt vmcnt(" #n ")" ::: "memory")
#define WAIT_L(n) asm volatile("s_waitcnt lgkmcnt(" #n ")" ::: "memory")
#define BAR __builtin_amdgcn_s_barrier()
#define SCHED __builtin_amdgcn_sched_barrier(0)
#pragma unroll
    for (int a_ = 0; a_ < 2; ++a_)
#pragma unroll
        for (int b_ = 0; b_ < 2; ++b_)
#pragma unroll
            for (int m = 0; m < 4; ++m) { acc[a_][b_][m][0] = (f32x4){0.f, 0.f, 0.f, 0.f}; acc[a_][b_][m][1] = (f32x4){0.f, 0.f, 0.f, 0.f}; }
    bf16x8 At[4][2], B0[2][2], B1[2][2];
    const int nt = K >> 6;
    STAGE(SB(0, 0), Cm, 0, 0); STAGE(SA(0, 0), Rm, 0, 0);
    STAGE(SB(0, 1), Cm, 128, 0); STAGE(SA(0, 1), Rm, 128, 0);
    if (wr == 1) BAR;
    WAIT_V(4); BAR;
    STAGE(SB(1, 0), Cm, 0, 1); STAGE(SA(1, 0), Rm, 0, 1); STAGE(SB(1, 1), Cm, 128, 1);
    WAIT_V(6); BAR;
    for (int tt = 0; tt < nt - 2; tt += 2) {
        LDB(B0, 0, 0); SCHED; LDA(At, 0, 0); STAGE(SA(1, 1), Rm, 128, tt + 1);
        WAIT_L(8); BAR; WAIT_L(0); MMA(0, 0, At, B0); BAR; SCHED;
        LDB(B1, 0, 1); STAGE(SB(0, 0), Cm, 0, tt + 2);
        BAR; WAIT_L(0); MMA(0, 1, At, B1); BAR;
        LDA(At, 0, 1); STAGE(SA(0, 0), Rm, 0, tt + 2);
        BAR; WAIT_L(0); MMA(1, 0, At, B0); BAR; SCHED;
        STAGE(SB(0, 1), Cm, 128, tt + 2);
        WAIT_V(6); BAR; MMA(1, 1, At, B1); BAR;
        LDB(B0, 1, 0); SCHED; LDA(At, 1, 0); STAGE(SA(0, 1), Rm, 128, tt + 2);
        WAIT_L(8); BAR; WAIT_L(0); MMA(0, 0, At, B0); BAR; SCHED;
        LDB(B1, 1, 1); STAGE(SB(1, 0), Cm, 0, tt + 3);
        BAR; WAIT_L(0); MMA(0, 1, At, B1); BAR;
        LDA(At, 1, 1); STAGE(SA(1, 0), Rm, 0, tt + 3);
        BAR; WAIT_L(0); MMA(1, 0, At, B0); BAR; SCHED;
        STAGE(SB(1, 1), Cm, 128, tt + 3);
        WAIT_V(6); BAR; MMA(1, 1, At, B1); BAR;
    }
    { LDB(B0, 0, 0); LDA(At, 0, 0); STAGE(SA(1, 1), Rm, 128, nt - 1);
      BAR; WAIT_L(0); MMA(0, 0, At, B0); BAR;
      LDB(B1, 0, 1); BAR; WAIT_L(0); MMA(0, 1, At, B1); BAR;
      LDA(At, 0, 1); WAIT_V(4); BAR; WAIT_L(0); MMA(1, 0, At, B0); MMA(1, 1, At, B1); BAR; }
    { LDB(B0, 1, 0); LDA(At, 1, 0); WAIT_V(2); BAR; WAIT_L(0); MMA(0, 0, At, B0); BAR;
      LDB(B1, 1, 1); WAIT_V(0); BAR; WAIT_L(0); MMA(0, 1, At, B1); BAR;
      LDA(At, 1, 1); BAR; WAIT_L(0); MMA(1, 0, At, B0); MMA(1, 1, At, B1); BAR; }
    if (wr == 0) BAR;
#undef SA
#undef SB
#undef STAGE
#undef LDA
#undef LDB
#undef MMA
}

DI void grp16(const f32x4 (&acc)[2][2][4][2], int ai, int bj, int nn, float sc, float (&lo)[8], float (&hi)[8]) {
#pragma unroll
    for (int j = 0; j < 4; ++j) {
        lo[j] = acc[ai][bj][0][nn][j] * sc; lo[4 + j] = acc[ai][bj][1][nn][j] * sc;
        hi[j] = acc[ai][bj][2][nn][j] * sc; hi[4 + j] = acc[ai][bj][3][nn][j] * sc;
    }
}
DI void st8(bf16_t* dst, const float (&v)[8]) { u32x4 o = {pk2(v[0], v[1]), pk2(v[2], v[3]), pk2(v[4], v[5]), pk2(v[6], v[7])}; *(u32x4*)dst = o; }

DI void tile_map(int t, int& mt, int& nt) {
    const int round = t >> 8, b = t & 255, x = b & 7, j = b >> 3;
    const int rg = round & 1, cgp = round >> 1;
    mt = 64 * rg + 8 * x + (j & 7); nt = 4 * cgp + (j >> 3);
}

DI void tile_rstd(const float* __restrict__ ssq, int m0, char* lds) {
    __syncthreads();
    const int t = tid();
    if (t < 256) {
        const f32x4* p = (const f32x4*)(ssq + (size_t)(m0 + t) * 16);
        const f32x4 a = p[0], b = p[1], c = p[2], d = p[3];
        const float sm = ((a[0] + a[1]) + (a[2] + a[3])) + ((b[0] + b[1]) + (b[2] + b[3])) + ((c[0] + c[1]) + (c[2] + c[3])) + ((d[0] + d[1]) + (d[2] + d[3]));
        ((float*)(lds + LDS_RS))[t] = __builtin_amdgcn_rsqf(sm * (1.f / 1024.f) + kEps);
    }
}

DI int v2logical(int v) { const int m = (v >> 4) & 3, fq = (v >> 2) & 3, j = v & 3; return (v & ~63) + 32 * (m >> 1) + 8 * fq + 4 * (m & 1) + j; }
DI int inproj_actual(int L) {
    if (L < 1024) { const int i = L >> 8, w = L & 255; return (w < 128 ? 512 : 1024) + 128 * i + (w & 127); }
    if (L < 2048) { L -= 1024; const int i = L >> 8, w = L & 255; return (w < 128 ? 0 : 1536) + 128 * i + (w & 127); }
    return L;
}

DI void convert_job(const float* __restrict__ src, int ld, int K, int Nv, int mode, int coloff, const float* __restrict__ rowscale,
                    bf16_t* __restrict__ dst, char* lds) {
    float (*tl)[65] = (float (*)[65])lds;
    const int t = tid();
    const int tiles_k = K >> 6, tiles_v = Nv >> 6;
    for (int tile = blockIdx.x; tile < tiles_k * tiles_v; tile += gridDim.x) {
        const int tk = tile % tiles_k, tv = tile / tiles_k, k0 = tk * 64, v0 = tv * 64;
        {
            const int v = t & 63, kk = t >> 6;
            int L = v2logical(v0 + v);
            if (mode) { const int g = (v0 + v) >= 2048 ? ((v0 + v) - 2048) >> 9 : -1; if (g == 2 || g == 6) L = v0 + v; }
            const int col = mode ? inproj_actual(L) : coloff + L;
#pragma unroll
            for (int i = 0; i < 8; ++i) {
                const int k = kk + 8 * i;
                float xv = src[(size_t)(k0 + k) * ld + col];
                if (rowscale) xv *= rowscale[k0 + k];
                tl[k][v] = xv;
            }
        }
        __syncthreads();
        {
            const int vv = t >> 3, kc = t & 7;
            u32x4 o;
            o[0] = pk2(tl[8 * kc + 0][vv], tl[8 * kc + 1][vv]); o[1] = pk2(tl[8 * kc + 2][vv], tl[8 * kc + 3][vv]);
            o[2] = pk2(tl[8 * kc + 4][vv], tl[8 * kc + 5][vv]); o[3] = pk2(tl[8 * kc + 6][vv], tl[8 * kc + 7][vv]);
            *(u32x4*)(dst + (size_t)(v0 + vv) * K + k0 + 8 * kc) = o;
        }
        __syncthreads();
    }
}

DI void rope_tables(const Params& P) {
    float* ct = (float*)(P.ws + OFF_COS); float* sn = (float*)(P.ws + OFF_SIN);
    for (int idx = blockIdx.x * 512 + tid(); idx < kS * 32; idx += gridDim.x * 512) {
        const int pos = idx >> 5, i = idx & 31;
        const float inv = fexp2(-(float)i * (13.287712379549449f / 32.f));
        const float ang = (float)pos * inv;
        const double rev = (double)ang * 0.15915494309189535;
        const float fr = (float)(rev - floor(rev));
        ct[idx] = __builtin_amdgcn_cosf(fr); sn[idx] = __builtin_amdgcn_sinf(fr);
    }
}

DI void x_to_bf16_ssq(const float* __restrict__ src, bf16_t* __restrict__ dst, float* __restrict__ ssq) {
    const int lane = tid() & 63, wave = tid() >> 6;
    for (int row = blockIdx.x * 8 + wave; row < kT; row += gridDim.x * 8) {
        const f32x4* r = (const f32x4*)(src + (size_t)row * 1024);
        f32x4 v[4]; float ss = 0.f;
#pragma unroll
        for (int i = 0; i < 2; ++i) { v[2 * i] = r[2 * lane + 128 * i]; v[2 * i + 1] = r[2 * lane + 1 + 128 * i]; }
#pragma unroll
        for (int i = 0; i < 4; ++i) ss += v[i][0] * v[i][0] + v[i][1] * v[i][1] + v[i][2] * v[i][2] + v[i][3] * v[i][3];
#pragma unroll
        for (int o = 32; o >= 1; o >>= 1) ss += __shfl_xor(ss, o);
#pragma unroll
        for (int i = 0; i < 2; ++i) {
            u32x4 o = {pk2(v[2 * i][0], v[2 * i][1]), pk2(v[2 * i][2], v[2 * i][3]), pk2(v[2 * i + 1][0], v[2 * i + 1][1]), pk2(v[2 * i + 1][2], v[2 * i + 1][3])};
            *(u32x4*)(dst + (size_t)row * 1024 + 8 * lane + 512 * i) = o;
        }
        if (lane < 16) ssq[(size_t)row * 16 + lane] = lane == 0 ? ss : 0.f;
    }
}

DI void p_to_bf16(const float* __restrict__ src, bf16_t* __restrict__ dst) {
    const size_t n8 = (size_t)kT * 256 / 8;
    for (size_t i = (size_t)blockIdx.x * 512 + tid(); i < n8; i += (size_t)gridDim.x * 512) {
        const f32x4 a = ((const f32x4*)src)[2 * i], b = ((const f32x4*)src)[2 * i + 1];
        u32x4 o = {pk2(a[0], a[1]), pk2(a[2], a[3]), pk2(b[0], b[1]), pk2(b[2], b[3])};
        ((u32x4*)dst)[i] = o;
    }
}

#define LANE_DECODE const int t_ = tid(), wid = t_ >> 6, lane = t_ & 63, wr = wid >> 2, wc = wid & 3, fr = lane & 15, fq = lane >> 4

DI void inproj_epilogue(const Params& P, int layer, const f32x4 (&acc)[2][2][4][2], int m0, int n0, const char* lds) {
    LANE_DECODE; (void)lane;
    const float* rsl = (const float*)(lds + LDS_RS);
#pragma unroll
    for (int bj = 0; bj < 2; ++bj)
#pragma unroll
        for (int nn = 0; nn < 2; ++nn) {
            const int rl = bj * 128 + wc * 32 + nn * 16 + fr;
            const size_t tok = (size_t)m0 + rl;
            const float rr = rsl[rl];
            if (n0 < 2048) {
                float l0[8], h0[8], l1[8], h1[8];
                grp16(acc, 0, bj, nn, rr, l0, h0); grp16(acc, 1, bj, nn, rr, l1, h1);
                const bool iscu = n0 < 1024;
                const int ch = 128 * ((iscu ? n0 : n0 - 1024) >> 8) + 64 * wr + 8 * fq;
#pragma unroll
                for (int i = 0; i < 8; ++i) { l0[i] *= iscu ? l1[i] : silu(l1[i]); h0[i] *= iscu ? h1[i] : silu(h1[i]); }
                bf16_t* d = slotp(P, iscu ? SL_CU : SL_BZ) + tok * 512 + ch;
                st8(d, l0); st8(d + 32, h0);
            } else {
#pragma unroll
                for (int ai = 0; ai < 2; ++ai) {
                    const int ncol = n0 + ai * 128 + wr * 64;
                    const int grp = (ncol - 2048) >> 9, cin = (ncol - 2048) & 511;
                    float lo[8], hi[8];
                    grp16(acc, ai, bj, nn, rr, lo, hi);
                    if (grp == 0 || grp == 1) {
                        if (grp == 0) {
#pragma unroll
                            for (int i = 0; i < 8; ++i) { lo[i] *= 0.125f * kLog2e; hi[i] *= 0.125f * kLog2e; }
                        }
                        bf16_t* d = slotp(P, grp == 0 ? SL_SQ : SL_SK) + tok * 512 + cin + 8 * fq;
                        st8(d, lo); st8(d + 32, hi);
                    } else if (grp == 3 || grp == 7) {
#pragma unroll
                        for (int i = 0; i < 8; ++i) { lo[i] = silu(lo[i]); hi[i] = silu(hi[i]); }
                        bf16_t* d = slotp(P, grp == 3 ? SL_SZ : SL_DZ) + tok * 512 + cin + 8 * fq;
                        st8(d, lo); st8(d + 32, hi);
                    } else {
                        const float* wv = (grp == 4 ? P.dqn : P.dkn) + layer * 64;
                        float ss = 0.f;
#pragma unroll
                        for (int i = 0; i < 8; ++i) ss += lo[i] * lo[i] + hi[i] * hi[i];
                        ss += __shfl_xor(ss, 16); ss += __shfl_xor(ss, 32);
                        const float rs = __builtin_amdgcn_rsqf(ss * (1.f / 64.f) + kEps);
                        const float osc = grp == 4 ? 0.125f * kLog2e : 1.f;
                        const int pos = (int)(tok & (kS - 1));
                        const float* cp = (const float*)(P.ws + OFF_COS) + pos * 32 + 8 * fq;
                        const float* sp = (const float*)(P.ws + OFF_SIN) + pos * 32 + 8 * fq;
#pragma unroll
                        for (int q4 = 0; q4 < 2; ++q4) {
                            const f32x4 c4 = *(const f32x4*)(cp + 4 * q4), s4 = *(const f32x4*)(sp + 4 * q4);
                            const f32x4 w0 = *(const f32x4*)(wv + 8 * fq + 4 * q4), w1 = *(const f32x4*)(wv + 32 + 8 * fq + 4 * q4);
#pragma unroll
                            for (int j = 0; j < 4; ++j) {
                                const int i = 4 * q4 + j;
                                const float y0 = lo[i] * rs * w0[j], y1 = hi[i] * rs * w1[j];
                                lo[i] = (y0 * c4[j] - y1 * s4[j]) * osc; hi[i] = (y0 * s4[j] + y1 * c4[j]) * osc;
                            }
                        }
                        bf16_t* d = slotp(P, grp == 4 ? SL_DQ : SL_DK) + tok * 512 + cin + 8 * fq;
                        st8(d, lo); st8(d + 32, hi);
                    }
                }
            }
            __builtin_amdgcn_sched_barrier(0);
        }
}

DI void vT_epilogue(const Params& P, const f32x4 (&acc)[2][2][4][2], int m0, int n0, const char* lds) {
    LANE_DECODE; (void)lane;
    const float* rsl = (const float*)(lds + LDS_RS);
    const int grp = (n0 - 2048) >> 9;
#pragma unroll
    for (int ai = 0; ai < 2; ++ai)
#pragma unroll
        for (int m = 0; m < 4; ++m) {
            const int rb0 = ai * 128 + wr * 64 + m * 16;
            const int tb = m0 + rb0, b = tb / kS, pos0 = tb & (kS - 1);
            const f32x4 r4 = *(const f32x4*)(rsl + rb0 + 4 * fq);
            const int tp = 4 * (fq >> 1) + 8 * (fq & 1);
#pragma unroll
            for (int bj = 0; bj < 2; ++bj)
#pragma unroll
                for (int nn = 0; nn < 2; ++nn) {
                    const int cin = (n0 - 2048 + bj * 128 + wc * 32 + nn * 16 + fr) & 511;
                    bf16_t* rowp = grp == 2 ? slotp(P, SL_SVT) + ((size_t)(b * 8 + (cin >> 6)) * 64 + (cin & 63)) * kS + pos0
                                            : slotp(P, SL_DVT) + ((size_t)(b * 4 + (cin >> 7)) * 128 + (cin & 127)) * kS + pos0;
                    const f32x4 v = acc[ai][bj][m][nn];
                    u32x2 o = {pk2(v[0] * r4[0], v[1] * r4[1]), pk2(v[2] * r4[2], v[3] * r4[3])};
                    *(u32x2*)(rowp + tp) = o;
                }
        }
}

DI void inproj_phase(const Params& P, int layer, char* lds) {
    const bf16_t* xb = (const bf16_t*)(P.ws + ((layer & 1) ? OFF_HB : OFF_XN));
    const float* ssq = (const float*)(P.ws + OFF_SSQA);
    const bf16_t* wt = wtp(P, layer, W_IN);
    for (int t = blockIdx.x; t < 128 * 24; t += gridDim.x) {
        int mt, nt; tile_map(t, mt, nt);
        const int m0 = mt * 256, n0 = nt * 256;
        tile_rstd(ssq, m0, lds);
        f32x4 acc[2][2][4][2];
        const int grp = n0 >= 2048 ? (n0 - 2048) >> 9 : -1;
        if (grp == 2 || grp == 6) {
            gemm8(acc, xb + (size_t)m0 * 1024, wt + (size_t)n0 * 1024, 1024, lds);
            __syncthreads();
            vT_epilogue(P, acc, m0, n0, lds);
        } else {
            gemm8(acc, wt + (size_t)n0 * 1024, xb + (size_t)m0 * 1024, 1024, lds);
            __syncthreads();
            inproj_epilogue(P, layer, acc, m0, n0, lds);
        }
    }
}

DI void conv_pass(const Params& P, int layer) {
    const bf16_t* cu = slotp(P, SL_CU); bf16_t* bz = slotp(P, SL_BZ);
    const float* cw = P.conv_w + layer * 3 * 512;
    for (int idx = blockIdx.x * 512 + tid(); idx < kT * 64; idx += gridDim.x * 512) {
        const int tok = idx >> 6, c8 = (idx & 63) * 8, pos = tok & (kS - 1);
        const u32x4 z4 = {0u, 0u, 0u, 0u};
        const u32x4 c2 = *(const u32x4*)(cu + (size_t)tok * 512 + c8);
        const u32x4 c1 = pos >= 1 ? *(const u32x4*)(cu + (size_t)(tok - 1) * 512 + c8) : z4;
        const u32x4 c0 = pos >= 2 ? *(const u32x4*)(cu + (size_t)(tok - 2) * 512 + c8) : z4;
        const u32x4 bv = *(const u32x4*)(bz + (size_t)tok * 512 + c8);
        u32x4 o;
#pragma unroll
        for (int j = 0; j < 4; ++j) {
            const int ch = c8 + 2 * j;
            const float r0 = bf_lo(bv[j]) * (cw[ch] * bf_lo(c0[j]) + cw[512 + ch] * bf_lo(c1[j]) + cw[1024 + ch] * bf_lo(c2[j]));
            const float r1 = bf_hi(bv[j]) * (cw[ch + 1] * bf_hi(c0[j]) + cw[512 + ch + 1] * bf_hi(c1[j]) + cw[1024 + ch + 1] * bf_hi(c2[j]));
            o[j] = pk2(r0, r1);
        }
        *(u32x4*)(bz + (size_t)tok * 512 + c8) = o;
    }
}

DI bf16x8 pack8(const f32x16& v, int s) {
    u32x4 p = {pk2(v[8 * s], v[8 * s + 1]), pk2(v[8 * s + 2], v[8 * s + 3]), pk2(v[8 * s + 4], v[8 * s + 5]), pk2(v[8 * s + 6], v[8 * s + 7])};
    return __builtin_bit_cast(bf16x8, p);
}

DI void diff_pass(const bf16_t* __restrict__ qrow  , const bf16_t* __restrict__ kg, const bf16_t* __restrict__ vg,
                  int nkt, int q0, float negM2, f32x16 (&O)[4], float& lsum, char* lds) {
    const int t = tid(), lane = t & 63, wv = t >> 6, h = lane >> 5, l31 = lane & 31, f = (lane >> 1) & 7;
    const int lr = t >> 3, lc = t & 7;
    const int sc = (lc ^ ((lr >> 1) & 7)) - lc;
    const bf16_t* kgs = kg + sc * 8;
    const bf16_t* vgs = vg + sc * 8;
    const int wb = wv * 1024;
    const int qpos = q0 + l31;
    bf16x8 qf[4];
#pragma unroll
    for (int ks = 0; ks < 4; ++ks) qf[ks] = *(const bf16x8*)(qrow + 16 * ks + 8 * h);
#pragma unroll
    for (int d = 0; d < 4; ++d) O[d] = zero16();
    lsum = 0.f;
    const f32x16 minit = splat16(negM2);
    __syncthreads();
    __builtin_amdgcn_global_load_lds((const unsigned*)kgs, (lds_ptr_t)(lds + wb), 16, 0, 0);
    __builtin_amdgcn_global_load_lds((const unsigned*)vgs, (lds_ptr_t)(lds + 8192 + wb), 16, 0, 0);
    __builtin_amdgcn_global_load_lds((const unsigned*)(vgs + (size_t)64 * kS), (lds_ptr_t)(lds + 16384 + wb), 16, 0, 0);
    asm volatile("s_waitcnt vmcnt(0)" ::: "memory");
    __syncthreads();
    for (int kt = 0; kt < nkt; ++kt) {
        char* st = lds + (kt & 1) * 24576;
        if (kt + 1 < nkt) {
            char* st2 = lds + ((kt + 1) & 1) * 24576 + wb;
            __builtin_amdgcn_global_load_lds((const unsigned*)(kgs + (size_t)(kt + 1) * 64 * 512), (lds_ptr_t)(st2), 16, 0, 0);
            __builtin_amdgcn_global_load_lds((const unsigned*)(vgs + (kt + 1) * 64), (lds_ptr_t)(st2 + 8192), 16, 0, 0);
            __builtin_amdgcn_global_load_lds((const unsigned*)(vgs + (size_t)64 * kS + (kt + 1) * 64), (lds_ptr_t)(st2 + 16384), 16, 0, 0);
        }
        __builtin_amdgcn_sched_barrier(0);
        if (kt * 64 <= q0 + 31) {
            f32x16 Sx[2];
            {
                bf16x8 kf[2][4];
#pragma unroll
                for (int kb = 0; kb < 2; ++kb)
#pragma unroll
                    for (int ks = 0; ks < 4; ++ks) kf[kb][ks] = *(const bf16x8*)(st + (32 * kb + l31) * 128 + (((2 * ks + h) ^ f) << 4));
                __builtin_amdgcn_sched_barrier(0);
#pragma unroll
                for (int ks = 0; ks < 4; ++ks)
#pragma unroll
                    for (int kb = 0; kb < 2; ++kb) Sx[kb] = ks == 0 ? MFMA(kf[kb][0], qf[0], minit) : MFMA(kf[kb][ks], qf[ks], Sx[kb]);
            }
            if (kt * 64 + 63 > q0) {
#pragma unroll
                for (int kb = 0; kb < 2; ++kb)
#pragma unroll
                    for (int i = 0; i < 16; ++i) {
                        float p = fexp2(Sx[kb][i]);
                        const int key = kt * 64 + 32 * kb + (i & 3) + 8 * (i >> 2) + 4 * h;
                        if (key > qpos) p = 0.f;
                        lsum += p; Sx[kb][i] = p;
                    }
            } else {
                float l0 = 0.f, l1 = 0.f;
#pragma unroll
                for (int i = 0; i < 16; ++i) { const float p0 = fexp2(Sx[0][i]), p1 = fexp2(Sx[1][i]); l0 += p0; l1 += p1; Sx[0][i] = p0; Sx[1][i] = p1; }
                lsum += l0 + l1;
            }
            bf16x8 pf[4];
            pf[0] = pack8(Sx[0], 0); pf[1] = pack8(Sx[0], 1); pf[2] = pack8(Sx[1], 0); pf[3] = pack8(Sx[1], 1);
            {
                bf16x8 vf[2][4];
#pragma unroll
                for (int db = 0; db < 4; ++db) vf[0][db] = *(const bf16x8*)(st + 8192 + (32 * db + l31) * 128 + ((h ^ f) << 4));
#pragma unroll
                for (int s = 0; s < 4; ++s) {
                    if (s < 3) {
#pragma unroll
                        for (int db = 0; db < 4; ++db) vf[(s + 1) & 1][db] = *(const bf16x8*)(st + 8192 + (32 * db + l31) * 128 + (((2 * (s + 1) + h) ^ f) << 4));
                    }
#pragma unroll
                    for (int db = 0; db < 4; ++db) O[db] = MFMA(vf[s & 1][db], pf[s], O[db]);
                    __builtin_amdgcn_sched_barrier(0);
                }
            }
        }
        asm volatile("s_waitcnt vmcnt(0)" ::: "memory");
        __syncthreads();
    }
    lsum += __shfl_xor(lsum, 32);
}

DI void diff_item(const Params& P, int layer, int b, int hd, int qt, float lam, float omli, float negM2, char* lds) {
    const int t = tid(), lane = t & 63, w = t >> 6, h = lane >> 5, l31 = lane & 31;
    const int lr = t >> 3, lc = t & 7;
    bf16_t* dq = slotp(P, SL_DQ); const bf16_t* dk = slotp(P, SL_DK); const bf16_t* dvT = slotp(P, SL_DVT); const bf16_t* dz = slotp(P, SL_DZ);
    const int q0 = qt * 256 + 32 * w;
    const size_t tokq = (size_t)b * kS + q0 + l31;
    const int nkt = (qt + 1) * 4;
    const bf16_t* vg = dvT + ((size_t)(b * 4 + hd) * 128 + lr) * kS + lc * 8;
    u32x4* o0s = (u32x4*)(lds + 49152) + t;
    f32x16 O[4]; float lsum;
#pragma unroll 1
    for (int c = 0; c < 2; ++c) {
        const bf16_t* kg = dk + ((size_t)b * kS + lr) * 512 + hd * 128 + c * 64 + lc * 8;
        diff_pass(dq + tokq * 512 + hd * 128 + c * 64, kg, vg, nkt, q0, negM2, O, lsum, lds);
        if (c == 0) {
            const float inv = frcp(lsum);
#pragma unroll
            for (int db = 0; db < 4; ++db)
#pragma unroll
                for (int i = 0; i < 2; ++i) {
                    u32x4 pkd = {pk2(O[db][8 * i] * inv, O[db][8 * i + 1] * inv), pk2(O[db][8 * i + 2] * inv, O[db][8 * i + 3] * inv),
                                 pk2(O[db][8 * i + 4] * inv, O[db][8 * i + 5] * inv), pk2(O[db][8 * i + 6] * inv, O[db][8 * i + 7] * inv)};
                    o0s[(db * 2 + i) * 512] = pkd;
                }
        }
    }
    const float inv = frcp(lsum) * lam;
    float ss = 0.f;
#pragma unroll
    for (int db = 0; db < 4; ++db) {
#pragma unroll
        for (int i2 = 0; i2 < 2; ++i2) {
            const u32x4 pkd = o0s[(db * 2 + i2) * 512];
#pragma unroll
            for (int j = 0; j < 4; ++j) {
                const int i = 4 * i2 + j;
                const float a = bf_lo(pkd[j]) - O[db][2 * i] * inv, c = bf_hi(pkd[j]) - O[db][2 * i + 1] * inv;
                O[db][2 * i] = a; O[db][2 * i + 1] = c; ss += a * a + c * c;
            }
        }
        __builtin_amdgcn_sched_barrier(0);
    }
    ss += __shfl_xor(ss, 32);
    const float rs = __builtin_amdgcn_rsqf(ss * (1.f / 128.f) + kEps) * omli;
    const float* sw = P.subln + layer * 128;
#pragma unroll
    for (int db = 0; db < 4; ++db) {
#pragma unroll
        for (int q4 = 0; q4 < 4; ++q4) {
            const int dv = 32 * db + 8 * q4 + 4 * h;
            const f32x4 w4 = *(const f32x4*)(sw + dv);
            const u32x2 z2 = *(const u32x2*)(dz + tokq * 512 + hd * 128 + dv);
            const float r0 = O[db][4 * q4] * rs * w4[0] * bf_lo(z2[0]), r1 = O[db][4 * q4 + 1] * rs * w4[1] * bf_hi(z2[0]);
            const float r2 = O[db][4 * q4 + 2] * rs * w4[2] * bf_lo(z2[1]), r3 = O[db][4 * q4 + 3] * rs * w4[3] * bf_hi(z2[1]);
            u32x2 o = {pk2(r0, r1), pk2(r2, r3)};
            *(u32x2*)(dq + tokq * 512 + hd * 128 + dv) = o;
        }
        __builtin_amdgcn_sched_barrier(0);
    }
}

constexpr float kSbExit = -24.f * 1.4426950408889634f;

DI void sb_item(const Params& P, int b, int hd, int qt, char* lds) {
    const int t = tid(), lane = t & 63, w = t >> 6, h = lane >> 5, l31 = lane & 31, f = (lane >> 1) & 7;
    const int lr = t >> 3, lc = t & 7;
    const int wofs = lr * 128 + ((lc ^ ((lr >> 1) & 7)) << 4);
    bf16_t* sq = slotp(P, SL_SQ); const bf16_t* sk = slotp(P, SL_SK); const bf16_t* svT = slotp(P, SL_SVT); const bf16_t* sz = slotp(P, SL_SZ);
    const int q0 = qt * 256 + 32 * w, qpos = q0 + l31;
    const size_t tokq = (size_t)b * kS + qpos;
    volatile int* flags = (volatile int*)(lds + 32768);
    bf16x8 qf[4];
#pragma unroll
    for (int ks = 0; ks < 4; ++ks) qf[ks] = *(const bf16x8*)(sq + tokq * 512 + hd * 64 + 16 * ks + 8 * h);
    f32x16 O[2]; O[0] = zero16(); O[1] = zero16();
    float R = 0.f; bool done = false;
    const bf16_t* kg = sk + ((size_t)b * kS + lr) * 512 + hd * 64 + lc * 8;
    const bf16_t* vg = svT + ((size_t)(b * 8 + hd) * 64 + lr) * kS + lc * 8;
    const int ktop = qt * 4 + 3;
    const int scd = ((lc ^ ((lr >> 1) & 7)) - lc) * 8;
    const bf16_t* kgs = kg + scd; const bf16_t* vgs = vg + scd;
    const int wb = w * 1024;
    __builtin_amdgcn_global_load_lds((const unsigned*)(kgs + (size_t)ktop * 64 * 512), (lds_ptr_t)(lds + wb), 16, 0, 0);
    __builtin_amdgcn_global_load_lds((const unsigned*)(vgs + ktop * 64), (lds_ptr_t)(lds + 8192 + wb), 16, 0, 0);
    asm volatile("s_waitcnt vmcnt(0)" ::: "memory");
    __syncthreads();
    for (int kt = ktop, it = 0; kt >= 0; --kt, ++it) {
        char* st = lds + (it & 1) * 16384;
        const bool more = kt > 0;
        if (more) {
            char* st2 = lds + ((it + 1) & 1) * 16384 + wb;
            __builtin_amdgcn_global_load_lds((const unsigned*)(kgs + (size_t)(kt - 1) * 64 * 512), (lds_ptr_t)(st2), 16, 0, 0);
            __builtin_amdgcn_global_load_lds((const unsigned*)(vgs + (kt - 1) * 64), (lds_ptr_t)(st2 + 8192), 16, 0, 0);
        }
        __builtin_amdgcn_sched_barrier(0);
        if (!done && kt * 64 < q0 + 31) {
            f32x16 Z[2];
#pragma unroll
            for (int kb = 0; kb < 2; ++kb) {
                Z[kb] = zero16();
#pragma unroll
                for (int ks = 0; ks < 4; ++ks) {
                    const bf16x8 kf = *(const bf16x8*)(st + (32 * kb + l31) * 128 + (((2 * ks + h) ^ f) << 4));
                    Z[kb] = MFMA(kf, qf[ks], Z[kb]);
                }
            }
            const bool diag = kt * 64 + 63 >= q0;
            float run = R;
#pragma unroll
            for (int kb = 1; kb >= 0; --kb) {
                float Lv[16];
                if (diag) {
#pragma unroll
                    for (int i = 0; i < 16; ++i) {
                        const float z = Z[kb][i];
                        const float sp = fmaxf(z, 0.f) + flog2(1.f + fexp2(-fabsf(z)));
                        const int key = kt * 64 + 32 * kb + (i & 3) + 8 * (i >> 2) + 4 * h;
                        const bool past = key < qpos;
                        Lv[i] = past ? -sp : 0.f;
                        Z[kb][i] = past ? z : -1e30f;
                    }
                } else {
#pragma unroll
                    for (int i = 0; i < 16; ++i) {
                        const float z = Z[kb][i];
                        Lv[i] = -(fmaxf(z, 0.f) + flog2(1.f + fexp2(-fabsf(z))));
                    }
                }
                float cs[4], ps[4];
#pragma unroll
                for (int g = 0; g < 4; ++g) { cs[g] = (Lv[4 * g] + Lv[4 * g + 1]) + (Lv[4 * g + 2] + Lv[4 * g + 3]); ps[g] = __shfl_xor(cs[g], 32); }
#pragma unroll
                for (int g = 3; g >= 0; --g) {
                    const float off = run + (h == 0 ? ps[g] : 0.f);
                    const float l3 = off, l2 = l3 + Lv[4 * g + 3], l1 = l2 + Lv[4 * g + 2], l0 = l1 + Lv[4 * g + 1];
                    Z[kb][4 * g + 3] = fexp2(Z[kb][4 * g + 3] + Lv[4 * g + 3] + l3);
                    Z[kb][4 * g + 2] = fexp2(Z[kb][4 * g + 2] + Lv[4 * g + 2] + l2);
                    Z[kb][4 * g + 1] = fexp2(Z[kb][4 * g + 1] + Lv[4 * g + 1] + l1);
                    Z[kb][4 * g + 0] = fexp2(Z[kb][4 * g + 0] + Lv[4 * g + 0] + l0);
                    run += cs[g] + ps[g];
                }
            }
            R = run;
            bf16x8 pf[4];
            pf[0] = pack8(Z[0], 0); pf[1] = pack8(Z[0], 1); pf[2] = pack8(Z[1], 0); pf[3] = pack8(Z[1], 1);
#pragma unroll
            for (int s = 0; s < 4; ++s)
#pragma unroll
                for (int db = 0; db < 2; ++db) {
                    const bf16x8 vf = *(const bf16x8*)(st + 8192 + (32 * db + l31) * 128 + (((2 * s + h) ^ f) << 4));
                    O[db] = MFMA(vf, pf[s], O[db]);
                }
            done = __all(R < kSbExit) != 0;
        }
        if (lane == 0) flags[(it & 1) * 8 + w] = done ? 1 : 0;
        asm volatile("s_waitcnt vmcnt(0)" ::: "memory");
        __syncthreads();
        int alld = 1;
#pragma unroll
        for (int i = 0; i < 8; ++i) alld &= flags[(it & 1) * 8 + i];
        if (alld) break;
    }
#pragma unroll
    for (int db = 0; db < 2; ++db)
#pragma unroll
        for (int q4 = 0; q4 < 4; ++q4) {
            const int dv = 32 * db + 8 * q4 + 4 * h;
            const u32x2 z2 = *(const u32x2*)(sz + tokq * 512 + hd * 64 + dv);
            u32x2 o = {pk2(O[db][4 * q4] * bf_lo(z2[0]), O[db][4 * q4 + 1] * bf_hi(z2[0])), pk2(O[db][4 * q4 + 2] * bf_lo(z2[1]), O[db][4 * q4 + 3] * bf_hi(z2[1]))};
            *(u32x2*)(sq + tokq * 512 + hd * 64 + dv) = o;
        }
    __syncthreads();
}

DI void attn_phase(const Params& P, int layer, char* lds) {
    const bool conv_first = (blockIdx.x >> 3) & 1;
    if (conv_first) conv_pass(P, layer);
    const int lane = tid() & 63;
    float a1 = P.lq1[layer * 64 + lane] * P.lk1[layer * 64 + lane], a2 = P.lq2[layer * 64 + lane] * P.lk2[layer * 64 + lane];
    float mq = fabsf(P.dqn[layer * 64 + lane]), mk = fabsf(P.dkn[layer * 64 + lane]);
#pragma unroll
    for (int o = 32; o >= 1; o >>= 1) { a1 += __shfl_xor(a1, o); a2 += __shfl_xor(a2, o); mq = fmaxf(mq, __shfl_xor(mq, o)); mk = fmaxf(mk, __shfl_xor(mk, o)); }
    const float lam_init = 0.8f - 0.6f * __expf(-0.3f * (float)layer);
    const float lam = __expf(a1) - __expf(a2) + lam_init;
    const float negM2 = -(8.f * mq * mk * kLog2e);
    for (int i = blockIdx.x; i < 256; i += gridDim.x) {
        const int x = i & 7, j = i >> 3, bh = x * 2 + (j >> 4), pr = j & 15;
#pragma unroll 1
        for (int e = 0; e < 2; ++e) diff_item(P, layer, bh >> 2, bh & 3, e ? pr : 31 - pr, lam, 1.f - lam_init, negM2, lds);
    }
    for (int i = blockIdx.x; i < 1024; i += gridDim.x) {
        const int x = i & 7, j = i >> 3, bh = x * 4 + (j >> 5), qt = j & 31;
        sb_item(P, bh >> 3, bh & 7, qt, lds);
    }
    if (!conv_first) conv_pass(P, layer);
}

DI unsigned q8(float g) { return (unsigned)(g * 255.f + 0.5f); }
DI unsigned q8x4(float a, float b, float c, float d) { return q8(a) | (q8(b) << 8) | (q8(c) << 16) | (q8(d) << 24); }
DI float dq8(unsigned w, int k) { return (float)((w >> (8 * k)) & 255u) * (1.f / 255.f); }
DI u32x4* gate_slot(const Params& P, int tile, int j, int g8) { return (u32x4*)slotp(P, SL_SK) + ((size_t)(tile * 3 + j) * 8 + g8) * 512 + tid(); }

DI void gate_epilogue(const Params& P, int layer, int j, const f32x4 (&acc)[2][2][4][2], int tile, int n0, const char* lds) {
    LANE_DECODE; (void)lane;
    const float* rsl = (const float*)(lds + LDS_RS);
#pragma unroll
    for (int ai = 0; ai < 2; ++ai) {
        const int col = n0 + ai * 128 + wr * 64 + 8 * fq;
        const float* bg = P.b_gate + layer * 3072 + j * 1024 + col;
        const f32x4 b0 = *(const f32x4*)bg, b1 = *(const f32x4*)(bg + 4), b2 = *(const f32x4*)(bg + 32), b3 = *(const f32x4*)(bg + 36);
#pragma unroll
        for (int bj = 0; bj < 2; ++bj)
#pragma unroll
            for (int nn = 0; nn < 2; ++nn) {
                const int rl = bj * 128 + wc * 32 + nn * 16 + fr;
                float lo[8], hi[8];
                grp16(acc, ai, bj, nn, rsl[rl], lo, hi);
#pragma unroll
                for (int i = 0; i < 4; ++i) { lo[i] = sigm(lo[i] + b0[i]); lo[4 + i] = sigm(lo[4 + i] + b1[i]); hi[i] = sigm(hi[i] + b2[i]); hi[4 + i] = sigm(hi[4 + i] + b3[i]); }
                u32x4 o = {q8x4(lo[0], lo[1], lo[2], lo[3]), q8x4(lo[4], lo[5], lo[6], lo[7]), q8x4(hi[0], hi[1], hi[2], hi[3]), q8x4(hi[4], hi[5], hi[6], hi[7])};
                *gate_slot(P, tile, j, ai * 4 + bj * 2 + nn) = o;
                __builtin_amdgcn_sched_barrier(0);
            }
    }
}

DI void y_epilogue(const Params& P, int j, bf16_t* __restrict__ hb, const f32x4 (&acc)[2][2][4][2], int tile, int m0, int n0) {
    LANE_DECODE; (void)lane;
#pragma unroll
    for (int ai = 0; ai < 2; ++ai)
#pragma unroll
        for (int bj = 0; bj < 2; ++bj)
#pragma unroll
            for (int nn = 0; nn < 2; ++nn) {
                const size_t tok = (size_t)m0 + bj * 128 + wc * 32 + nn * 16 + fr;
                const int col = n0 + ai * 128 + wr * 64 + 8 * fq;
                float lo[8], hi[8];
                grp16(acc, ai, bj, nn, 1.f, lo, hi);
                const u32x4 gq = *gate_slot(P, tile, j, ai * 4 + bj * 2 + nn);
                bf16_t* hp = hb + tok * 1024 + col;
                u32x4 h0 = {0u, 0u, 0u, 0u}, h1 = {0u, 0u, 0u, 0u};
                if (j > 0) { h0 = *(const u32x4*)hp; h1 = *(const u32x4*)(hp + 32); }
                u32x4 o0, o1;
#pragma unroll
                for (int i = 0; i < 4; ++i) {
                    o0[i] = pk2(bf_lo(h0[i]) + dq8(gq[i >> 1], 2 * (i & 1)) * lo[2 * i], bf_hi(h0[i]) + dq8(gq[i >> 1], 2 * (i & 1) + 1) * lo[2 * i + 1]);
                    o1[i] = pk2(bf_lo(h1[i]) + dq8(gq[2 + (i >> 1)], 2 * (i & 1)) * hi[2 * i], bf_hi(h1[i]) + dq8(gq[2 + (i >> 1)], 2 * (i & 1) + 1) * hi[2 * i + 1]);
                }
                *(u32x4*)hp = o0; *(u32x4*)(hp + 32) = o1;
                __builtin_amdgcn_sched_barrier(0);
            }
}

DI void merge_phase(const Params& P, int layer, char* lds) {
    const bf16_t* xb = (const bf16_t*)(P.ws + ((layer & 1) ? OFF_HB : OFF_XN));
    bf16_t* hb = (bf16_t*)(P.ws + ((layer & 1) ? OFF_XN : OFF_HB));
    const float* ssq = (const float*)(P.ws + OFF_SSQA);
    for (int t = blockIdx.x; t < 128 * 4; t += gridDim.x) {
        int mt, nt; tile_map(t, mt, nt);
        const int m0 = mt * 256, n0 = nt * 256;
        tile_rstd(ssq, m0, lds);
#pragma unroll 1
        for (int j = 0; j < 3; ++j) {
            f32x4 acc[2][2][4][2];
            gemm8(acc, wtp(P, layer, W_G) + (size_t)(j * 1024 + n0) * 1024, xb + (size_t)m0 * 1024, 1024, lds);
            __syncthreads();
            gate_epilogue(P, layer, j, acc, t, n0, lds);
            const bf16_t* Aj = slotp(P, j == 0 ? SL_BZ : (j == 1 ? SL_SQ : SL_DQ));
            const bf16_t* Wj = wtp(P, layer, j == 0 ? W_OC : (j == 1 ? W_OSB : W_OD));
            gemm8(acc, Wj + (size_t)n0 * 512, Aj + (size_t)m0 * 512, 512, lds);
            y_epilogue(P, j, hb, acc, t, m0, n0);
        }
    }
    p_to_bf16(P.p + (size_t)layer * kT * 256, slotp(P, SL_CU));
}

template <bool XBF, bool WF32>
DI void resid_epilogue(const float* __restrict__ xs, const bf16_t* __restrict__ xsb, float* __restrict__ out, bf16_t* __restrict__ xbn, float* __restrict__ ssq,
                       const f32x4 (&acc)[2][2][4][2], int m0, int n0, int nt, bool wxb = true) {
    LANE_DECODE; (void)lane;
#pragma unroll
    for (int bj = 0; bj < 2; ++bj)
#pragma unroll
        for (int nn = 0; nn < 2; ++nn) {
            const size_t tok = (size_t)m0 + bj * 128 + wc * 32 + nn * 16 + fr;
            float ss = 0.f;
#pragma unroll
            for (int ai = 0; ai < 2; ++ai) {
                float lo[8], hi[8];
                grp16(acc, ai, bj, nn, 1.f, lo, hi);
                const size_t o = tok * 1024 + n0 + ai * 128 + wr * 64 + 8 * fq;
                if (XBF) {
                    const u32x4 xl = *(const u32x4*)(xsb + o), xh = *(const u32x4*)(xsb + o + 32);
#pragma unroll
                    for (int j = 0; j < 4; ++j) { lo[2 * j] += bf_lo(xl[j]); lo[2 * j + 1] += bf_hi(xl[j]); hi[2 * j] += bf_lo(xh[j]); hi[2 * j + 1] += bf_hi(xh[j]); }
                } else {
#pragma unroll
                    for (int q4 = 0; q4 < 2; ++q4) {
                        const f32x4 xl = *(const f32x4*)(xs + o + 4 * q4), xh = *(const f32x4*)(xs + o + 32 + 4 * q4);
#pragma unroll
                        for (int j = 0; j < 4; ++j) { lo[4 * q4 + j] += xl[j]; hi[4 * q4 + j] += xh[j]; }
                    }
                }
#pragma unroll
                for (int i = 0; i < 8; ++i) ss += lo[i] * lo[i] + hi[i] * hi[i];
                if (WF32) {
#pragma unroll
                    for (int q4 = 0; q4 < 2; ++q4) {
                        *(f32x4*)(out + o + 4 * q4) = (f32x4){lo[4 * q4], lo[4 * q4 + 1], lo[4 * q4 + 2], lo[4 * q4 + 3]};
                        *(f32x4*)(out + o + 32 + 4 * q4) = (f32x4){hi[4 * q4], hi[4 * q4 + 1], hi[4 * q4 + 2], hi[4 * q4 + 3]};
                    }
                }
                if (wxb) { st8(xbn + o, lo); st8(xbn + o + 32, hi); }
            }
            ss += __shfl_xor(ss, 16); ss += __shfl_xor(ss, 32);
            if (wxb && fq < 2) ssq[tok * 16 + 4 * nt + 2 * fq + wr] = fq == 0 ? ss : 0.f;
            __builtin_amdgcn_sched_barrier(0);
        }
}

DI void wout_phase(const Params& P, int layer, char* lds) {
    const bf16_t* hb = (const bf16_t*)(P.ws + ((layer & 1) ? OFF_XN : OFF_HB));
    bf16_t* xb2 = (bf16_t*)(P.ws + ((layer & 1) ? OFF_HB : OFF_XN));
    const float* xs = layer == 0 ? P.x : P.out;
    for (int t = blockIdx.x; t < 128 * 4; t += gridDim.x) {
        int mt, nt; tile_map(t, mt, nt);
        const int m0 = mt * 256, n0 = nt * 256;
        f32x4 acc[2][2][4][2];
        gemm8(acc, wtp(P, layer, W_OUT) + (size_t)n0 * 1024, hb + (size_t)m0 * 1024, 1024, lds);
        resid_epilogue<false, false>(xs, nullptr, nullptr, xb2, (float*)(P.ws + OFF_SSQB), acc, m0, n0, nt);
    }
}

DI u32x4* ple_slot(const Params& P, int tile, int g8) { return (u32x4*)slotp(P, SL_SQ) + ((size_t)tile * 8 + g8) * 512 + tid(); }

DI void ple_gate_store(const Params& P, const f32x4 (&acc)[2][2][4][2], int tile, const char* lds) {
    LANE_DECODE; (void)lane; (void)wr; (void)fq;
    const float* rsl = (const float*)(lds + LDS_RS);
#pragma unroll
    for (int ai = 0; ai < 2; ++ai)
#pragma unroll
        for (int bj = 0; bj < 2; ++bj)
#pragma unroll
            for (int nn = 0; nn < 2; ++nn) {
                float lo[8], hi[8];
                grp16(acc, ai, bj, nn, rsl[bj * 128 + wc * 32 + nn * 16 + fr], lo, hi);
#pragma unroll
                for (int i = 0; i < 8; ++i) { lo[i] = sigm(lo[i]); hi[i] = sigm(hi[i]); }
                u32x4 o = {q8x4(lo[0], lo[1], lo[2], lo[3]), q8x4(lo[4], lo[5], lo[6], lo[7]), q8x4(hi[0], hi[1], hi[2], hi[3]), q8x4(hi[4], hi[5], hi[6], hi[7])};
                *ple_slot(P, tile, ai * 4 + bj * 2 + nn) = o;
                __builtin_amdgcn_sched_barrier(0);
            }
}

DI void ple_gate_apply(const Params& P, f32x4 (&acc)[2][2][4][2], int tile) {
#pragma unroll
    for (int ai = 0; ai < 2; ++ai)
#pragma unroll
        for (int bj = 0; bj < 2; ++bj)
#pragma unroll
            for (int nn = 0; nn < 2; ++nn) {
                const u32x4 gq = *ple_slot(P, tile, ai * 4 + bj * 2 + nn);
#pragma unroll
                for (int e = 0; e < 8; ++e) {
                    acc[ai][bj][e >> 2][nn][e & 3] *= dq8(gq[e >> 2], e & 3);
                    acc[ai][bj][2 + (e >> 2)][nn][e & 3] *= dq8(gq[2 + (e >> 2)], e & 3);
                }
                __builtin_amdgcn_sched_barrier(0);
            }
}

DI void ple_phase(const Params& P, int layer, char* lds) {
    const bf16_t* xb2 = (const bf16_t*)(P.ws + ((layer & 1) ? OFF_HB : OFF_XN));
    bf16_t* xb3 = (bf16_t*)(P.ws + ((layer & 1) ? OFF_XN : OFF_HB));
    const bf16_t* pb = slotp(P, SL_CU);
    for (int t = blockIdx.x; t < 128 * 4; t += gridDim.x) {
        int mt, nt; tile_map(t, mt, nt);
        const int m0 = mt * 256, n0 = nt * 256;
        tile_rstd((const float*)(P.ws + OFF_SSQB), m0, lds);
        f32x4 acc[2][2][4][2];
        gemm8(acc, wtp(P, layer, W_PG) + (size_t)n0 * 1024, xb2 + (size_t)m0 * 1024, 1024, lds);
        __syncthreads();
        ple_gate_store(P, acc, t, lds);
        gemm8(acc, wtp(P, layer, W_PLE) + (size_t)n0 * 256, pb + (size_t)m0 * 256, 256, lds);
        ple_gate_apply(P, acc, t);
        resid_epilogue<true, true>(nullptr, xb2, P.out, xb3, (float*)(P.ws + OFF_SSQA), acc, m0, n0, nt, layer == 0);
    }
}

DI void prologue_phase(const Params& P, char* lds) {
    for (int l = 0; l < 2; ++l) {
        convert_job(P.w_in + (size_t)l * 1024 * 9216, 9216, 1024, 6144, 1, 0, P.norm_w + l * 1024, wtp(P, l, W_IN), lds);
        convert_job(P.w_in + (size_t)l * 1024 * 9216, 9216, 1024, 3072, 0, 6144, P.norm_w + l * 1024, wtp(P, l, W_G), lds);
        convert_job(P.w_oc + (size_t)l * 512 * 1024, 1024, 512, 1024, 0, 0, nullptr, wtp(P, l, W_OC), lds);
        convert_job(P.w_osb + (size_t)l * 512 * 1024, 1024, 512, 1024, 0, 0, nullptr, wtp(P, l, W_OSB), lds);
        convert_job(P.w_od + (size_t)l * 512 * 1024, 1024, 512, 1024, 0, 0, nullptr, wtp(P, l, W_OD), lds);
        convert_job(P.w_out + (size_t)l * 1024 * 1024, 1024, 1024, 1024, 0, 0, nullptr, wtp(P, l, W_OUT), lds);
        convert_job(P.w_pg + (size_t)l * 1024 * 1024, 1024, 1024, 1024, 0, 0, P.ple_norm + l * 1024, wtp(P, l, W_PG), lds);
        convert_job(P.w_ple + (size_t)l * 256 * 1024, 1024, 256, 1024, 0, 0, nullptr, wtp(P, l, W_PLE), lds);
    }
    rope_tables(P);
    x_to_bf16_ssq(P.x, (bf16_t*)(P.ws + OFF_XN), (float*)(P.ws + OFF_SSQA));
}

constexpr int kNumPhases = 11;
DI void run_phase(const Params& P, int ph, char* lds) {
    if (ph == 0) { prologue_phase(P, lds); return; }
    const int layer = (ph - 1) / 5, s = (ph - 1) % 5;
    switch (s) {
        case 0: inproj_phase(P, layer, lds); break;
        case 1: attn_phase(P, layer, lds); break;
        case 2: merge_phase(P, layer, lds); break;
        case 3: wout_phase(P, layer, lds); break;
        default: ple_phase(P, layer, lds); break;
    }
}


#define XB_TMO      128
#define XB_XCNT(j)  (256  + 64 * (j))
#define XB_XSUB(j)  (1280 + 64 * (j))
#define XB_XGEN(j)  (2304 + 64 * (j))
#define XB_TOP      3328
#define XB_TOPGEN   3392
#define XCD_BAR_WORDS 3456
#define XB_SPIN_CAP (1u << 22)
#define LAS __attribute__((address_space(3)))
DI unsigned xb_ld(unsigned* p) { return __hip_atomic_load(p, __ATOMIC_RELAXED, __HIP_MEMORY_SCOPE_AGENT); }
DI unsigned xb_add(unsigned* p, unsigned v) { return __hip_atomic_fetch_add(p, v, __ATOMIC_RELAXED, __HIP_MEMORY_SCOPE_AGENT); }
DI unsigned xb_xcc_id() { return (unsigned)__builtin_amdgcn_s_getreg((3 << 11) | 20) & 0xFu; }
#define XB_SPIN(cond, bar) do { unsigned _sp = 0; while (cond) { __builtin_amdgcn_s_sleep(1); \
    if ((++_sp & 255u) == 0u) { if (xb_ld(&(bar)[XB_TMO])) break; if (_sp > XB_SPIN_CAP) { atomicAdd(&(bar)[XB_TMO], 1u); break; } } } } while (0)
struct XcdBarrier { unsigned* bar; unsigned x; volatile LAS unsigned* st; };
DI XcdBarrier xcd_barrier_post(unsigned* bar, volatile LAS unsigned* st) {
    XcdBarrier b; b.bar = bar; b.x = xb_xcc_id(); b.st = st;
    if (threadIdx.x == 0) (void)xb_add(&bar[XB_XCNT(b.x)], 1u);
    return b;
}
DI void xcd_barrier_complete(unsigned* bar, unsigned x, unsigned& nloc, unsigned& nx) {
    const unsigned G = gridDim.x * gridDim.y * gridDim.z;
    unsigned sum, cnt, mine, sp = 0u;
    for (;;) {
        sum = 0u; cnt = 0u; mine = 0u;
#pragma unroll
        for (unsigned j = 0; j < 16; ++j) { const unsigned c = xb_ld(&bar[XB_XCNT(j)]); sum += c; cnt += (c > 0u) ? 1u : 0u; mine = (j == x) ? c : mine; }
        if (sum == G) break;
        __builtin_amdgcn_s_sleep(1);
        if ((++sp & 255u) == 0u) { if (xb_ld(&bar[XB_TMO])) break; if (sp > XB_SPIN_CAP) { atomicAdd(&bar[XB_TMO], 1u); break; } }
    }
    nloc = mine > 0u ? mine : 1u; nx = cnt > 0u ? cnt : 1u;
}
DI void xcd_barrier(const XcdBarrier& b) {
    asm volatile("s_waitcnt vmcnt(0)" ::: "memory");
    __syncthreads();
    if (threadIdx.x == 0) {
        unsigned* bar = b.bar;
        __builtin_amdgcn_s_waitcnt(0);
        unsigned nloc = b.st[0], nx = b.st[1];
        if (nloc == 0u) { xcd_barrier_complete(bar, b.x, nloc, nx); b.st[0] = nloc; b.st[1] = nx; }
        const unsigned old = xb_add(&bar[XB_XSUB(b.x)], 1u);
        const unsigned gen = old / nloc;
        if (old + 1u == (gen + 1u) * nloc) {
            __builtin_amdgcn_fence(__ATOMIC_RELEASE, "agent");
            asm volatile("s_waitcnt vmcnt(0)" ::: "memory");
            const unsigned og = xb_add(&bar[XB_TOP], 1u);
            const unsigned tg = og / nx;
            if (og + 1u == (tg + 1u) * nx) xb_add(&bar[XB_TOPGEN], 1u);
            else XB_SPIN(xb_ld(&bar[XB_TOPGEN]) == tg, bar);
            __builtin_amdgcn_fence(__ATOMIC_ACQUIRE, "agent");
            xb_add(&bar[XB_XGEN(b.x)], 1u);
            asm volatile("s_waitcnt vmcnt(0)" ::: "memory");
        } else {
            XB_SPIN(xb_ld(&bar[XB_XGEN(b.x)]) == gen, bar);
            __builtin_amdgcn_fence(__ATOMIC_ACQUIRE, "agent");
            asm volatile("s_waitcnt vmcnt(0)" ::: "memory");
        }
    }
    __syncthreads();
}

__global__ void __launch_bounds__(512) fwd_megakernel(Params P) {
    __shared__ __attribute__((aligned(16))) char smem[LDS_BYTES];
    unsigned* bar = (unsigned*)(P.ws + OFF_BAR);
    volatile LAS unsigned* xst = (volatile LAS unsigned*)(smem + LDS_XB);
    if (threadIdx.x < 4) xst[threadIdx.x] = 0u;
    if (blockIdx.x == 0) for (int i = threadIdx.x; i < XCD_BAR_WORDS; i += 512) bar[i] = 0u;
    __syncthreads();
    for (int ph = P.ph_lo; ph < P.ph_hi; ++ph) {
        run_phase(P, ph, smem);
        if (ph + 1 < P.ph_hi) {
            if (ph == P.ph_lo) { cg::this_grid().sync(); (void)xcd_barrier_post((unsigned*)(P.ws + OFF_BAR), (volatile LAS unsigned*)(smem + LDS_XB)); }
            else { XcdBarrier xb; xb.bar = (unsigned*)(P.ws + OFF_BAR); xb.x = xb_xcc_id(); xb.st = (volatile LAS unsigned*)(smem + LDS_XB); xcd_barrier(xb); }
        }
    }
}

extern "C" void kernel_launch(void* const* d_in, const int* in_sizes, int n_in, void* d_out, int out_size, void* d_ws, size_t ws_size,
                              hipStream_t stream) {
    if (ws_size < WS_NEED) { fprintf(stderr, "workspace too small: %zu < %zu\n", ws_size, (size_t)WS_NEED); return; }
    Params P{};
    P.x = (const float*)d_in[0]; P.p = (const float*)d_in[1]; P.norm_w = (const float*)d_in[2]; P.w_in = (const float*)d_in[3];
    P.b_gate = (const float*)d_in[4]; P.conv_w = (const float*)d_in[5]; P.dqn = (const float*)d_in[6]; P.dkn = (const float*)d_in[7];
    P.lq1 = (const float*)d_in[8]; P.lk1 = (const float*)d_in[9]; P.lq2 = (const float*)d_in[10]; P.lk2 = (const float*)d_in[11];
    P.subln = (const float*)d_in[12]; P.w_oc = (const float*)d_in[13]; P.w_osb = (const float*)d_in[14]; P.w_od = (const float*)d_in[15];
    P.w_out = (const float*)d_in[16]; P.ple_norm = (const float*)d_in[17]; P.w_pg = (const float*)d_in[18]; P.w_ple = (const float*)d_in[19];
    P.out = (float*)d_out; P.ws = (char*)d_ws;
#if MK_MULTI
    for (int ph = 0; ph < kNumPhases; ++ph) {
        P.ph_lo = ph; P.ph_hi = ph + 1;
        hipLaunchKernelGGL(fwd_megakernel, dim3(256), dim3(512), 0, stream, P);
    }
#else
    static int grid_blocks = 0;
    if (!grid_blocks) {
        int dev = 0, cus = 0, per_cu = 0;
        (void)hipGetDevice(&dev);
        (void)hipDeviceGetAttribute(&cus, hipDeviceAttributeMultiprocessorCount, dev);
        (void)hipOccupancyMaxActiveBlocksPerMultiprocessor(&per_cu, fwd_megakernel, 512, 0);
        if (per_cu < 1) per_cu = 1;
        if (per_cu > 1) per_cu = 1;
        grid_blocks = cus * per_cu;
    }
    P.ph_lo = 0; P.ph_hi = kNumPhases;
    void* args[] = {&P};
    hipError_t e = hipLaunchCooperativeKernel((void*)fwd_megakernel, dim3(grid_blocks), dim3(512), args, 0, stream);
    if (e != hipSuccess) fprintf(stderr, "cooperative launch failed: %s (grid %d)\n", hipGetErrorString(e), grid_blocks);
#endif
}
```

```cpp
#include <hip/hip_runtime.h>
#include <hip/hip_cooperative_groups.h>
#include <cstdio>
#include <cstdint>
namespace cg = cooperative_groups;

#ifndef MK_MULTI
#define MK_MULTI 0
#endif
#ifndef PROBE_DUP
#define PROBE_DUP -1
#endif

typedef unsigned short bf16_t;
typedef short bf16x8 __attribute__((ext_vector_type(8)));
typedef float f32x16 __attribute__((ext_vector_type(16)));
typedef float f32x4 __attribute__((ext_vector_type(4)));
typedef float f32x2 __attribute__((ext_vector_type(2)));
typedef unsigned u32x4 __attribute__((ext_vector_type(4)));
typedef unsigned u32x2 __attribute__((ext_vector_type(2)));
typedef __bf16 bf2_t __attribute__((ext_vector_type(2)));
#define DI __device__ __forceinline__
#define MFMA(a, b, c) __builtin_amdgcn_mfma_f32_32x32x16_bf16((a), (b), (c), 0, 0, 0)

constexpr int kB = 4, kS = 8192, kT = kB * kS;
constexpr float kEps = 1e-6f;
constexpr float kLog2e = 1.4426950408889634f;
constexpr float kLn2 = 0.6931471805599453f;
constexpr size_t MiB = 1u << 20;
constexpr size_t OFF_COS = 0, OFF_SIN = 1 * MiB, OFF_WT = 4 * MiB, OFF_XN = 56 * MiB, OFF_HB = 120 * MiB, OFF_PROJ = 184 * MiB;
constexpr size_t PROJ_SLOT = 32 * MiB;
constexpr size_t OFF_SSQA = 2 * MiB, OFF_SSQB = 504 * MiB, OFF_BAR = 506 * MiB;
constexpr size_t WS_NEED = 507 * MiB;
enum { SL_CU = 0, SL_BZ = 1, SL_SQ = 2, SL_DQ = 3, SL_SK = 4, SL_SVT = 5, SL_SZ = 6, SL_DK = 7, SL_DVT = 8, SL_DZ = 9 };
constexpr int LDS_RS = 131072;
constexpr size_t W_IN = 0, W_G = W_IN + 6144 * 1024, W_OC = W_G + 3072 * 1024, W_OSB = W_OC + 512 * 1024, W_OD = W_OSB + 512 * 1024,
                 W_OUT = W_OD + 512 * 1024, W_PG = W_OUT + 1024 * 1024, W_PLE = W_PG + 1024 * 1024, W_LAYER = W_PLE + 256 * 1024;
constexpr int LDS_XB = 132096;
constexpr int LDS_BYTES = 133120;

struct Params {
    const float* x; const float* p; const float* norm_w; const float* w_in; const float* b_gate; const float* conv_w;
    const float* dqn; const float* dkn; const float* lq1; const float* lk1; const float* lq2; const float* lk2;
    const float* subln; const float* w_oc; const float* w_osb; const float* w_od; const float* w_out; const float* ple_norm;
    const float* w_pg; const float* w_ple;
    float* out; char* ws;
    int ph_lo, ph_hi;
};

DI int tid() { int t = __builtin_amdgcn_workitem_id_x(); asm volatile("" : "+v"(t)); return t; }
typedef unsigned u32x2_t __attribute__((ext_vector_type(2)));
DI void swap32(unsigned& a, unsigned& b) { const u32x2_t r = __builtin_amdgcn_permlane32_swap(a, b, false, false); a = r[0]; b = r[1]; }
DI unsigned pk2(float a, float b) { f32x2 v = {a, b}; return __builtin_bit_cast(unsigned, __builtin_convertvector(v, bf2_t)); }
DI float bf_lo(unsigned u) { return __uint_as_float(u << 16); }
DI float bf_hi(unsigned u) { return __uint_as_float(u & 0xffff0000u); }
DI float fexp2(float x) { return __builtin_amdgcn_exp2f(x); }
DI float flog2(float x) { return __builtin_amdgcn_logf(x); }
DI float frcp(float x) { return __builtin_amdgcn_rcpf(x); }
DI float sigm(float x) { return frcp(1.f + fexp2(-kLog2e * x)); }
DI float silu(float x) { return x * sigm(x); }
DI bf16_t* slotp(const Params& P, int s) { return (bf16_t*)(P.ws + OFF_PROJ + (size_t)s * PROJ_SLOT); }
DI bf16_t* wtp(const Params& P, int layer, size_t off) { return (bf16_t*)(P.ws + OFF_WT) + (size_t)layer * W_LAYER + off; }

DI void st16(bf16_t* dst, const f32x16& v) {
    u32x4 a = {pk2(v[0], v[1]), pk2(v[2], v[3]), pk2(v[4], v[5]), pk2(v[6], v[7])};
    u32x4 b = {pk2(v[8], v[9]), pk2(v[10], v[11]), pk2(v[12], v[13]), pk2(v[14], v[15])};
    *(u32x4*)dst = a; *(u32x4*)(dst + 8) = b;
}
DI f32x16 zero16() { f32x16 z; for (int i = 0; i < 16; ++i) z[i] = 0.f; return z; }
DI f32x16 splat16(float v) { f32x16 z; for (int i = 0; i < 16; ++i) z[i] = v; return z; }

typedef __attribute__((address_space(3))) void* lds_ptr_t;
#define MFMA16(a, b, c) __builtin_amdgcn_mfma_f32_16x16x32_bf16((a), (b), (c), 0, 0, 0)
DI int lds_byte(int r, int c) { const int st = (r >> 4) * 2 + (c >> 5), rr = r & 15, cc = c & 31, ob = rr * 64 + cc * 2; return st * 1024 + (ob ^ (((ob >> 9) & 1) << 5)); }
DI void stage_rc(int b, int& R, int& C) { const int st = b / 1024, sb = b % 1024, swz = sb ^ (((sb >> 9) & 1) << 5); R = (st >> 1) * 16 + swz / 64; C = (st & 1) * 32 + (swz % 64) / 2; }

DI void gemm8(f32x4 (&acc)[2][2][4][2], const bf16_t* __restrict__ Rm, const bf16_t* __restrict__ Cm, int K, char* shm) {
    constexpr int HT2 = 128 * 64 * 2;
    const int t = tid(), wid = t >> 6, lane = t & 63, wr = wid >> 2, wc = wid & 3, fr = lane & 15, fq = lane >> 4;
#define SA(b, hh) (shm + ((b) * 2 + (hh)) * HT2)
#define SB(b, hh) (shm + (4 + (b) * 2 + (hh)) * HT2)
    int gofs[2];
#pragma unroll
    for (int i = 0; i < 2; ++i) { int r_, c_; stage_rc(t * 16 + i * 8192, r_, c_); gofs[i] = r_ * K + c_; }
    const int wb = wid * 1024;
#define STAGE(P, BASE, br, kt) do { const bf16_t* g_ = (BASE) + (size_t)(br) * K + (size_t)(kt) * 64; \
        _Pragma("unroll") for (int i_ = 0; i_ < 2; ++i_) \
            __builtin_amdgcn_global_load_lds((const unsigned*)(g_ + gofs[i_]), (lds_ptr_t)((P) + wb + i_ * 8192), 16, 0, 0); } while (0)
#define LDA(dst, b, hh) _Pragma("unroll") for (int m = 0; m < 4; ++m) _Pragma("unroll") for (int k = 0; k < 2; ++k) \
        dst[m][k] = *(const bf16x8*)(SA(b, hh) + lds_byte(wr * 64 + m * 16 + fr, k * 32 + fq * 8))
#define LDB(dst, b, hh) _Pragma("unroll") for (int n = 0; n < 2; ++n) _Pragma("unroll") for (int k = 0; k < 2; ++k) \
        dst[n][k] = *(const bf16x8*)(SB(b, hh) + lds_byte(wc * 32 + n * 16 + fr, k * 32 + fq * 8))
#define MMA(ai, bj, At_, Bt_) do { __builtin_amdgcn_s_setprio(1); \
        _Pragma("unroll") for (int m = 0; m < 4; ++m) _Pragma("unroll") for (int n = 0; n < 2; ++n) _Pragma("unroll") for (int k = 0; k < 2; ++k) \
            acc[ai][bj][m][n] = MFMA16(At_[m][k], Bt_[n][k], acc[ai][bj][m][n]); \
        __builtin_amdgcn_s_setprio(0); } while (0)
#define WAIT_V(n) asm volatile("s_waitcnt vmcnt(" #n ")" ::: "memory")
#define WAIT_L(n) asm volatile("s_waitcnt lgkmcnt(" #n ")" ::: "memory")
#define BAR __builtin_amdgcn_s_barrier()
#define SCHED __builtin_amdgcn_sched_barrier(0)
#pragma unroll
    for (int a_ = 0; a_ < 2; ++a_)
#pragma unroll
        for (int b_ = 0; b_ < 2; ++b_)
#pragma unroll
            for (int m = 0; m < 4; ++m) { acc[a_][b_][m][0] = (f32x4){0.f, 0.f, 0.f, 0.f}; acc[a_][b_][m][1] = (f32x4){0.f, 0.f, 0.f, 0.f}; }
    bf16x8 At[4][2], B0[2][2], B1[2][2];
    const int nt = K >> 6;
    STAGE(SB(0, 0), Cm, 0, 0); STAGE(SA(0, 0), Rm, 0, 0);
    STAGE(SB(0, 1), Cm, 128, 0); STAGE(SA(0, 1), Rm, 128, 0);
    if (wr == 1) BAR;
    WAIT_V(4); BAR;
    STAGE(SB(1, 0), Cm, 0, 1); STAGE(SA(1, 0), Rm, 0, 1); STAGE(SB(1, 1), Cm, 128, 1);
    WAIT_V(6); BAR;
    for (int tt = 0; tt < nt - 2; tt += 2) {
        LDB(B0, 0, 0); SCHED; LDA(At, 0, 0); STAGE(SA(1, 1), Rm, 128, tt + 1);
        WAIT_L(8); BAR; WAIT_L(0); MMA(0, 0, At, B0); BAR; SCHED;
        LDB(B1, 0, 1); STAGE(SB(0, 0), Cm, 0, tt + 2);
        BAR; WAIT_L(0); MMA(0, 1, At, B1); BAR;
        LDA(At, 0, 1); STAGE(SA(0, 0), Rm, 0, tt + 2);
        BAR; WAIT_L(0); MMA(1, 0, At, B0); BAR; SCHED;
        STAGE(SB(0, 1), Cm, 128, tt + 2);
        WAIT_V(6); BAR; MMA(1, 1, At, B1); BAR;
        LDB(B0, 1, 0); SCHED; LDA(At, 1, 0); STAGE(SA(0, 1), Rm, 128, tt + 2);
        WAIT_L(8); BAR; WAIT_L(0); MMA(0, 0, At, B0); BAR; SCHED;
        LDB(B1, 1, 1); STAGE(SB(1, 0), Cm, 0, tt + 3);
        BAR; WAIT_L(0); MMA(0, 1, At, B1); BAR;
        LDA(At, 1, 1); STAGE(SA(1, 0), Rm, 0, tt + 3);
        BAR; WAIT_L(0); MMA(1, 0, At, B0); BAR; SCHED;
        STAGE(SB(1, 1), Cm, 128, tt + 3);
        WAIT_V(6); BAR; MMA(1, 1, At, B1); BAR;
    }
    { LDB(B0, 0, 0); LDA(At, 0, 0); STAGE(SA(1, 1), Rm, 128, nt - 1);
      BAR; WAIT_L(0); MMA(0, 0, At, B0); BAR;
      LDB(B1, 0, 1); BAR; WAIT_L(0); MMA(0, 1, At, B1); BAR;
      LDA(At, 0, 1); WAIT_V(4); BAR; WAIT_L(0); MMA(1, 0, At, B0); MMA(1, 1, At, B1); BAR; }
    { LDB(B0, 1, 0); LDA(At, 1, 0); WAIT_V(2); BAR; WAIT_L(0); MMA(0, 0, At, B0); BAR;
      LDB(B1, 1, 1); WAIT_V(0); BAR; WAIT_L(0); MMA(0, 1, At, B1); BAR;
      LDA(At, 1, 1); BAR; WAIT_L(0); MMA(1, 0, At, B0); MMA(1, 1, At, B1); BAR; }
    if (wr == 0) BAR;
#undef SA
#undef SB
#undef STAGE
#undef LDA
#undef LDB
#undef MMA
}

DI void grp16(const f32x4 (&acc)[2][2][4][2], int ai, int bj, int nn, float sc, float (&lo)[8], float (&hi)[8]) {
#pragma unroll
    for (int j = 0; j < 4; ++j) {
        lo[j] = acc[ai][bj][0][nn][j] * sc; lo[4 + j] = acc[ai][bj][1][nn][j] * sc;
        hi[j] = acc[ai][bj][2][nn][j] * sc; hi[4 + j] = acc[ai][bj][3][nn][j] * sc;
    }
}
DI void st8(bf16_t* dst, const float (&v)[8]) { u32x4 o = {pk2(v[0], v[1]), pk2(v[2], v[3]), pk2(v[4], v[5]), pk2(v[6], v[7])}; *(u32x4*)dst = o; }

DI void tile_map(int t, int& mt, int& nt) {
    const int round = t >> 8, b = t & 255, x = b & 7, j = b >> 3;
    const int rg = round & 1, cgp = round >> 1;
    mt = 64 * rg + 8 * x + (j & 7); nt = 4 * cgp + (j >> 3);
}

DI void tile_rstd(const float* __restrict__ ssq, int m0, char* lds) {
    __syncthreads();
    const int t = tid();
    if (t < 256) {
        const f32x4* p = (const f32x4*)(ssq + (size_t)(m0 + t) * 16);
        const f32x4 a = p[0], b = p[1], c = p[2], d = p[3];
        const float sm = ((a[0] + a[1]) + (a[2] + a[3])) + ((b[0] + b[1]) + (b[2] + b[3])) + ((c[0] + c[1]) + (c[2] + c[3])) + ((d[0] + d[1]) + (d[2] + d[3]));
        ((float*)(lds + LDS_RS))[t] = __builtin_amdgcn_rsqf(sm * (1.f / 1024.f) + kEps);
    }
}

DI int v2logical(int v) { const int m = (v >> 4) & 3, fq = (v >> 2) & 3, j = v & 3; return (v & ~63) + 32 * (m >> 1) + 8 * fq + 4 * (m & 1) + j; }
DI int inproj_actual(int L) {
    if (L < 1024) { const int i = L >> 8, w = L & 255; return (w < 128 ? 512 : 1024) + 128 * i + (w & 127); }
    if (L < 2048) { L -= 1024; const int i = L >> 8, w = L & 255; return (w < 128 ? 0 : 1536) + 128 * i + (w & 127); }
    return L;
}

DI void convert_job(const float* __restrict__ src, int ld, int K, int Nv, int mode, int coloff, const float* __restrict__ rowscale,
                    bf16_t* __restrict__ dst, char* lds) {
    float (*tl)[65] = (float (*)[65])lds;
    const int t = tid();
    const int tiles_k = K >> 6, tiles_v = Nv >> 6;
    for (int tile = blockIdx.x; tile < tiles_k * tiles_v; tile += gridDim.x) {
        const int tk = tile % tiles_k, tv = tile / tiles_k, k0 = tk * 64, v0 = tv * 64;
        {
            const int v = t & 63, kk = t >> 6;
            int L = v2logical(v0 + v);
            if (mode) { const int g = (v0 + v) >= 2048 ? ((v0 + v) - 2048) >> 9 : -1; if (g == 2 || g == 6) L = v0 + v; }
            const int col = mode ? inproj_actual(L) : coloff + L;
#pragma unroll
            for (int i = 0; i < 8; ++i) {
                const int k = kk + 8 * i;
                float xv = src[(size_t)(k0 + k) * ld + col];
                if (rowscale) xv *= rowscale[k0 + k];
                tl[k][v] = xv;
            }
        }
        __syncthreads();
        {
            const int vv = t >> 3, kc = t & 7;
            u32x4 o;
            o[0] = pk2(tl[8 * kc + 0][vv], tl[8 * kc + 1][vv]); o[1] = pk2(tl[8 * kc + 2][vv], tl[8 * kc + 3][vv]);
            o[2] = pk2(tl[8 * kc + 4][vv], tl[8 * kc + 5][vv]); o[3] = pk2(tl[8 * kc + 6][vv], tl[8 * kc + 7][vv]);
            *(u32x4*)(dst + (size_t)(v0 + vv) * K + k0 + 8 * kc) = o;
        }
        __syncthreads();
    }
}

DI void rope_tables(const Params& P) {
    float* ct = (float*)(P.ws + OFF_COS); float* sn = (float*)(P.ws + OFF_SIN);
    for (int idx = blockIdx.x * 512 + tid(); idx < kS * 32; idx += gridDim.x * 512) {
        const int pos = idx >> 5, i = idx & 31;
        const float inv = fexp2(-(float)i * (13.287712379549449f / 32.f));
        const float ang = (float)pos * inv;
        const double rev = (double)ang * 0.15915494309189535;
        const float fr = (float)(rev - floor(rev));
        ct[idx] = __builtin_amdgcn_cosf(fr); sn[idx] = __builtin_amdgcn_sinf(fr);
    }
}

DI void x_to_bf16_ssq(const float* __restrict__ src, bf16_t* __restrict__ dst, float* __restrict__ ssq) {
    const int lane = tid() & 63, wave = tid() >> 6;
    for (int row = blockIdx.x * 8 + wave; row < kT; row += gridDim.x * 8) {
        const f32x4* r = (const f32x4*)(src + (size_t)row * 1024);
        f32x4 v[4]; float ss = 0.f;
#pragma unroll
        for (int i = 0; i < 2; ++i) { v[2 * i] = r[2 * lane + 128 * i]; v[2 * i + 1] = r[2 * lane + 1 + 128 * i]; }
#pragma unroll
        for (int i = 0; i < 4; ++i) ss += v[i][0] * v[i][0] + v[i][1] * v[i][1] + v[i][2] * v[i][2] + v[i][3] * v[i][3];
#pragma unroll
        for (int o = 32; o >= 1; o >>= 1) ss += __shfl_xor(ss, o);
#pragma unroll
        for (int i = 0; i < 2; ++i) {
            u32x4 o = {pk2(v[2 * i][0], v[2 * i][1]), pk2(v[2 * i][2], v[2 * i][3]), pk2(v[2 * i + 1][0], v[2 * i + 1][1]), pk2(v[2 * i + 1][2], v[2 * i + 1][3])};
            *(u32x4*)(dst + (size_t)row * 1024 + 8 * lane + 512 * i) = o;
        }
        if (lane < 16) ssq[(size_t)row * 16 + lane] = lane == 0 ? ss : 0.f;
    }
}

DI void p_to_bf16(const float* __restrict__ src, bf16_t* __restrict__ dst) {
    const size_t n8 = (size_t)kT * 256 / 8;
    for (size_t i = (size_t)blockIdx.x * 512 + tid(); i < n8; i += (size_t)gridDim.x * 512) {
        const f32x4 a = ((const f32x4*)src)[2 * i], b = ((const f32x4*)src)[2 * i + 1];
        u32x4 o = {pk2(a[0], a[1]), pk2(a[2], a[3]), pk2(b[0], b[1]), pk2(b[2], b[3])};
        ((u32x4*)dst)[i] = o;
    }
}

#define LANE_DECODE const int t_ = tid(), wid = t_ >> 6, lane = t_ & 63, wr = wid >> 2, wc = wid & 3, fr = lane & 15, fq = lane >> 4

DI void inproj_epilogue(const Params& P, int layer, const f32x4 (&acc)[2][2][4][2], int m0, int n0, const char* lds) {
    LANE_DECODE; (void)lane;
    const float* rsl = (const float*)(lds + LDS_RS);
#pragma unroll
    for (int bj = 0; bj < 2; ++bj)
#pragma unroll
        for (int nn = 0; nn < 2; ++nn) {
            const int rl = bj * 128 + wc * 32 + nn * 16 + fr;
            const size_t tok = (size_t)m0 + rl;
            const float rr = rsl[rl];
            if (n0 < 2048) {
                float l0[8], h0[8], l1[8], h1[8];
                grp16(acc, 0, bj, nn, rr, l0, h0); grp16(acc, 1, bj, nn, rr, l1, h1);
                const bool iscu = n0 < 1024;
                const int ch = 128 * ((iscu ? n0 : n0 - 1024) >> 8) + 64 * wr + 8 * fq;
#pragma unroll
                for (int i = 0; i < 8; ++i) { l0[i] *= iscu ? l1[i] : silu(l1[i]); h0[i] *= iscu ? h1[i] : silu(h1[i]); }
                bf16_t* d = slotp(P, iscu ? SL_CU : SL_BZ) + tok * 512 + ch;
                st8(d, l0); st8(d + 32, h0);
            } else {
#pragma unroll
                for (int ai = 0; ai < 2; ++ai) {
                    const int ncol = n0 + ai * 128 + wr * 64;
                    const int grp = (ncol - 2048) >> 9, cin = (ncol - 2048) & 511;
                    float lo[8], hi[8];
                    grp16(acc, ai, bj, nn, rr, lo, hi);
                    if (grp == 0 || grp == 1) {
                        if (grp == 0) {
#pragma unroll
                            for (int i = 0; i < 8; ++i) { lo[i] *= 0.125f * kLog2e; hi[i] *= 0.125f * kLog2e; }
                        }
                        bf16_t* d = slotp(P, grp == 0 ? SL_SQ : SL_SK) + tok * 512 + cin + 8 * fq;
                        st8(d, lo); st8(d + 32, hi);
                    } else if (grp == 3 || grp == 7) {
#pragma unroll
                        for (int i = 0; i < 8; ++i) { lo[i] = silu(lo[i]); hi[i] = silu(hi[i]); }
                        bf16_t* d = slotp(P, grp == 3 ? SL_SZ : SL_DZ) + tok * 512 + cin + 8 * fq;
                        st8(d, lo); st8(d + 32, hi);
                    } else {
                        const float* wv = (grp == 4 ? P.dqn : P.dkn) + layer * 64;
                        float ss = 0.f;
#pragma unroll
                        for (int i = 0; i < 8; ++i) ss += lo[i] * lo[i] + hi[i] * hi[i];
                        ss += __shfl_xor(ss, 16); ss += __shfl_xor(ss, 32);
                        const float rs = __builtin_amdgcn_rsqf(ss * (1.f / 64.f) + kEps);
                        const float osc = grp == 4 ? 0.125f * kLog2e : 1.f;
                        const int pos = (int)(tok & (kS - 1));
                        const float* cp = (const float*)(P.ws + OFF_COS) + pos * 32 + 8 * fq;
                        const float* sp = (const float*)(P.ws + OFF_SIN) + pos * 32 + 8 * fq;
#pragma unroll
                        for (int q4 = 0; q4 < 2; ++q4) {
                            const f32x4 c4 = *(const f32x4*)(cp + 4 * q4), s4 = *(const f32x4*)(sp + 4 * q4);
                            const f32x4 w0 = *(const f32x4*)(wv + 8 * fq + 4 * q4), w1 = *(const f32x4*)(wv + 32 + 8 * fq + 4 * q4);
#pragma unroll
                            for (int j = 0; j < 4; ++j) {
                                const int i = 4 * q4 + j;
                                const float y0 = lo[i] * rs * w0[j], y1 = hi[i] * rs * w1[j];
                                lo[i] = (y0 * c4[j] - y1 * s4[j]) * osc; hi[i] = (y0 * s4[j] + y1 * c4[j]) * osc;
                            }
                        }
                        bf16_t* d = slotp(P, grp == 4 ? SL_DQ : SL_DK) + tok * 512 + cin + 8 * fq;
                        st8(d, lo); st8(d + 32, hi);
                    }
                }
            }
            __builtin_amdgcn_sched_barrier(0);
        }
}

DI void vT_epilogue(const Params& P, const f32x4 (&acc)[2][2][4][2], int m0, int n0, const char* lds) {
    LANE_DECODE; (void)lane;
    const float* rsl = (const float*)(lds + LDS_RS);
    const int grp = (n0 - 2048) >> 9;
#pragma unroll
    for (int ai = 0; ai < 2; ++ai)
#pragma unroll
        for (int m = 0; m < 4; ++m) {
            const int rb0 = ai * 128 + wr * 64 + m * 16;
            const int tb = m0 + rb0, b = tb / kS, pos0 = tb & (kS - 1);
            const f32x4 r4 = *(const f32x4*)(rsl + rb0 + 4 * fq);
            const int tp = 4 * (fq >> 1) + 8 * (fq & 1);
#pragma unroll
            for (int bj = 0; bj < 2; ++bj)
#pragma unroll
                for (int nn = 0; nn < 2; ++nn) {
                    const int cin = (n0 - 2048 + bj * 128 + wc * 32 + nn * 16 + fr) & 511;
                    bf16_t* rowp = grp == 2 ? slotp(P, SL_SVT) + ((size_t)(b * 8 + (cin >> 6)) * 64 + (cin & 63)) * kS + pos0
                                            : slotp(P, SL_DVT) + ((size_t)(b * 4 + (cin >> 7)) * 128 + (cin & 127)) * kS + pos0;
                    const f32x4 v = acc[ai][bj][m][nn];
                    u32x2 o = {pk2(v[0] * r4[0], v[1] * r4[1]), pk2(v[2] * r4[2], v[3] * r4[3])};
                    *(u32x2*)(rowp + tp) = o;
                }
        }
}

DI void inproj_phase(const Params& P, int layer, char* lds) {
    const bf16_t* xb = (const bf16_t*)(P.ws + ((layer & 1) ? OFF_HB : OFF_XN));
    const float* ssq = (const float*)(P.ws + OFF_SSQA);
    const bf16_t* wt = wtp(P, layer, W_IN);
    for (int t = blockIdx.x; t < 128 * 24; t += gridDim.x) {
        int mt, nt; tile_map(t, mt, nt);
        const int m0 = mt * 256, n0 = nt * 256;
        tile_rstd(ssq, m0, lds);
        f32x4 acc[2][2][4][2];
        const int grp = n0 >= 2048 ? (n0 - 2048) >> 9 : -1;
        if (grp == 2 || grp == 6) {
            gemm8(acc, xb + (size_t)m0 * 1024, wt + (size_t)n0 * 1024, 1024, lds);
            __syncthreads();
            vT_epilogue(P, acc, m0, n0, lds);
        } else {
            gemm8(acc, wt + (size_t)n0 * 1024, xb + (size_t)m0 * 1024, 1024, lds);
            __syncthreads();
            inproj_epilogue(P, layer, acc, m0, n0, lds);
        }
    }
}

DI void conv_pass(const Params& P, int layer) {
    const bf16_t* cu = slotp(P, SL_CU); bf16_t* bz = slotp(P, SL_BZ);
    const float* cw = P.conv_w + layer * 3 * 512;
    for (int idx = blockIdx.x * 512 + tid(); idx < kT * 64; idx += gridDim.x * 512) {
        const int tok = idx >> 6, c8 = (idx & 63) * 8, pos = tok & (kS - 1);
        const u32x4 z4 = {0u, 0u, 0u, 0u};
        const u32x4 c2 = *(const u32x4*)(cu + (size_t)tok * 512 + c8);
        const u32x4 c1 = pos >= 1 ? *(const u32x4*)(cu + (size_t)(tok - 1) * 512 + c8) : z4;
        const u32x4 c0 = pos >= 2 ? *(const u32x4*)(cu + (size_t)(tok - 2) * 512 + c8) : z4;
        const u32x4 bv = *(const u32x4*)(bz + (size_t)tok * 512 + c8);
        u32x4 o;
#pragma unroll
        for (int j = 0; j < 4; ++j) {
            const int ch = c8 + 2 * j;
            const float r0 = bf_lo(bv[j]) * (cw[ch] * bf_lo(c0[j]) + cw[512 + ch] * bf_lo(c1[j]) + cw[1024 + ch] * bf_lo(c2[j]));
            const float r1 = bf_hi(bv[j]) * (cw[ch + 1] * bf_hi(c0[j]) + cw[512 + ch + 1] * bf_hi(c1[j]) + cw[1024 + ch + 1] * bf_hi(c2[j]));
            o[j] = pk2(r0, r1);
        }
        *(u32x4*)(bz + (size_t)tok * 512 + c8) = o;
    }
}

DI bf16x8 pack8(const f32x16& v, int s) {
    u32x4 p = {pk2(v[8 * s], v[8 * s + 1]), pk2(v[8 * s + 2], v[8 * s + 3]), pk2(v[8 * s + 4], v[8 * s + 5]), pk2(v[8 * s + 6], v[8 * s + 7])};
    return __builtin_bit_cast(bf16x8, p);
}

DI void diff_pass(const bf16_t* __restrict__ qrow  , const bf16_t* __restrict__ kg, const bf16_t* __restrict__ vg,
                  int nkt, int q0, float negM2, f32x16 (&O)[4], float& lsum, char* lds) {
    const int t = tid(), lane = t & 63, wv = t >> 6, h = lane >> 5, l31 = lane & 31, f = (lane >> 1) & 7;
    const int lr = t >> 3, lc = t & 7;
    const int sc = (lc ^ ((lr >> 1) & 7)) - lc;
    const bf16_t* kgs = kg + sc * 8;
    const bf16_t* vgs = vg + sc * 8;
    const int wb = wv * 1024;
    const int qpos = q0 + l31;
    bf16x8 qf[4];
#pragma unroll
    for (int ks = 0; ks < 4; ++ks) qf[ks] = *(const bf16x8*)(qrow + 16 * ks + 8 * h);
#pragma unroll
    for (int d = 0; d < 4; ++d) O[d] = zero16();
    lsum = 0.f;
    const f32x16 minit = splat16(negM2);
    __syncthreads();
    __builtin_amdgcn_global_load_lds((const unsigned*)kgs, (lds_ptr_t)(lds + wb), 16, 0, 0);
    __builtin_amdgcn_global_load_lds((const unsigned*)vgs, (lds_ptr_t)(lds + 8192 + wb), 16, 0, 0);
    __builtin_amdgcn_global_load_lds((const unsigned*)(vgs + (size_t)64 * kS), (lds_ptr_t)(lds + 16384 + wb), 16, 0, 0);
    asm volatile("s_waitcnt vmcnt(0)" ::: "memory");
    __syncthreads();
    for (int kt = 0; kt < nkt; ++kt) {
        char* st = lds + (kt & 1) * 24576;
        if (kt + 1 < nkt) {
            char* st2 = lds + ((kt + 1) & 1) * 24576 + wb;
            __builtin_amdgcn_global_load_lds((const unsigned*)(kgs + (size_t)(kt + 1) * 64 * 512), (lds_ptr_t)(st2), 16, 0, 0);
            __builtin_amdgcn_global_load_lds((const unsigned*)(vgs + (kt + 1) * 64), (lds_ptr_t)(st2 + 8192), 16, 0, 0);
            __builtin_amdgcn_global_load_lds((const unsigned*)(vgs + (size_t)64 * kS + (kt + 1) * 64), (lds_ptr_t)(st2 + 16384), 16, 0, 0);
        }
        __builtin_amdgcn_sched_barrier(0);
        if (kt * 64 <= q0 + 31) {
            f32x16 Sx[2];
            {
                bf16x8 kf[2][4];
#pragma unroll
                for (int kb = 0; kb < 2; ++kb)
#pragma unroll
                    for (int ks = 0; ks < 4; ++ks) kf[kb][ks] = *(const bf16x8*)(st + (32 * kb + l31) * 128 + (((2 * ks + h) ^ f) << 4));
                __builtin_amdgcn_sched_barrier(0);
#pragma unroll
                for (int ks = 0; ks < 4; ++ks)
#pragma unroll
                    for (int kb = 0; kb < 2; ++kb) Sx[kb] = ks == 0 ? MFMA(kf[kb][0], qf[0], minit) : MFMA(kf[kb][ks], qf[ks], Sx[kb]);
            }
            if (kt * 64 + 63 > q0) {
#pragma unroll
                for (int kb = 0; kb < 2; ++kb)
#pragma unroll
                    for (int i = 0; i < 16; ++i) {
                        float p = fexp2(Sx[kb][i]);
                        const int key = kt * 64 + 32 * kb + (i & 3) + 8 * (i >> 2) + 4 * h;
                        if (key > qpos) p = 0.f;
                        lsum += p; Sx[kb][i] = p;
                    }
            } else {
                float l0 = 0.f, l1 = 0.f;
#pragma unroll
                for (int i = 0; i < 16; ++i) { const float p0 = fexp2(Sx[0][i]), p1 = fexp2(Sx[1][i]); l0 += p0; l1 += p1; Sx[0][i] = p0; Sx[1][i] = p1; }
                lsum += l0 + l1;
            }
            bf16x8 pf[4];
            pf[0] = pack8(Sx[0], 0); pf[1] = pack8(Sx[0], 1); pf[2] = pack8(Sx[1], 0); pf[3] = pack8(Sx[1], 1);
            {
                bf16x8 vf[2][4];
#pragma unroll
                for (int db = 0; db < 4; ++db) vf[0][db] = *(const bf16x8*)(st + 8192 + (32 * db + l31) * 128 + ((h ^ f) << 4));
#pragma unroll
                for (int s = 0; s < 4; ++s) {
                    if (s < 3) {
#pragma unroll
                        for (int db = 0; db < 4; ++db) vf[(s + 1) & 1][db] = *(const bf16x8*)(st + 8192 + (32 * db + l31) * 128 + (((2 * (s + 1) + h) ^ f) << 4));
                    }
#pragma unroll
                    for (int db = 0; db < 4; ++db) O[db] = MFMA(vf[s & 1][db], pf[s], O[db]);
                    __builtin_amdgcn_sched_barrier(0);
                }
            }
        }
        asm volatile("s_waitcnt vmcnt(0)" ::: "memory");
        __syncthreads();
    }
    lsum += __shfl_xor(lsum, 32);
}

DI void diff_item(const Params& P, int layer, int b, int hd, int qt, float lam, float omli, float negM2, char* lds) {
    const int t = tid(), lane = t & 63, w = t >> 6, h = lane >> 5, l31 = lane & 31;
    const int lr = t >> 3, lc = t & 7;
    bf16_t* dq = slotp(P, SL_DQ); const bf16_t* dk = slotp(P, SL_DK); const bf16_t* dvT = slotp(P, SL_DVT); const bf16_t* dz = slotp(P, SL_DZ);
    const int q0 = qt * 256 + 32 * w;
    const size_t tokq = (size_t)b * kS + q0 + l31;
    const int nkt = (qt + 1) * 4;
    const bf16_t* vg = dvT + ((size_t)(b * 4 + hd) * 128 + lr) * kS + lc * 8;
    u32x4* o0s = (u32x4*)(lds + 49152) + t;
    f32x16 O[4]; float lsum;
#pragma unroll 1
    for (int c = 0; c < 2; ++c) {
        const bf16_t* kg = dk + ((size_t)b * kS + lr) * 512 + hd * 128 + c * 64 + lc * 8;
        diff_pass(dq + tokq * 512 + hd * 128 + c * 64, kg, vg, nkt, q0, negM2, O, lsum, lds);
        if (c == 0) {
            const float inv = frcp(lsum);
#pragma unroll
            for (int db = 0; db < 4; ++db)
#pragma unroll
                for (int i = 0; i < 2; ++i) {
                    u32x4 pkd = {pk2(O[db][8 * i] * inv, O[db][8 * i + 1] * inv), pk2(O[db][8 * i + 2] * inv, O[db][8 * i + 3] * inv),
                                 pk2(O[db][8 * i + 4] * inv, O[db][8 * i + 5] * inv), pk2(O[db][8 * i + 6] * inv, O[db][8 * i + 7] * inv)};
                    o0s[(db * 2 + i) * 512] = pkd;
                }
        }
    }
    const float inv = frcp(lsum) * lam;
    float ss = 0.f;
#pragma unroll
    for (int db = 0; db < 4; ++db) {
#pragma unroll
        for (int i2 = 0; i2 < 2; ++i2) {
            const u32x4 pkd = o0s[(db * 2 + i2) * 512];
#pragma unroll
            for (int j = 0; j < 4; ++j) {
                const int i = 4 * i2 + j;
                const float a = bf_lo(pkd[j]) - O[db][2 * i] * inv, c = bf_hi(pkd[j]) - O[db][2 * i + 1] * inv;
                O[db][2 * i] = a; O[db][2 * i + 1] = c; ss += a * a + c * c;
            }
        }
        __builtin_amdgcn_sched_barrier(0);
    }
    ss += __shfl_xor(ss, 32);
    const float rs = __builtin_amdgcn_rsqf(ss * (1.f / 128.f) + kEps) * omli;
    const float* sw = P.subln + layer * 128;
#pragma unroll
    for (int db = 0; db < 4; ++db) {
#pragma unroll
        for (int p2 = 0; p2 < 2; ++p2) {
            unsigned ov[2][2];
#pragma unroll
            for (int e = 0; e < 2; ++e) {
                const int q4 = 2 * p2 + e, dv = 32 * db + 8 * q4 + 4 * h;
                const f32x4 w4 = *(const f32x4*)(sw + dv);
                const u32x2 z2 = *(const u32x2*)(dz + tokq * 512 + hd * 128 + dv);
                const float r0 = O[db][4 * q4] * rs * w4[0] * bf_lo(z2[0]), r1 = O[db][4 * q4 + 1] * rs * w4[1] * bf_hi(z2[0]);
                const float r2 = O[db][4 * q4 + 2] * rs * w4[2] * bf_lo(z2[1]), r3 = O[db][4 * q4 + 3] * rs * w4[3] * bf_hi(z2[1]);
                ov[e][0] = pk2(r0, r1); ov[e][1] = pk2(r2, r3);
            }
            swap32(ov[0][0], ov[1][0]); swap32(ov[0][1], ov[1][1]);
            u32x4 o = {ov[0][0], ov[0][1], ov[1][0], ov[1][1]};
            *(u32x4*)(dq + tokq * 512 + hd * 128 + 32 * db + 16 * p2 + 8 * h) = o;
        }
        __builtin_amdgcn_sched_barrier(0);
    }
}

constexpr float kSbExit = -24.f * 1.4426950408889634f;

DI void sb_item(const Params& P, int b, int hd, int qt, char* lds) {
    const int t = tid(), lane = t & 63, w = t >> 6, h = lane >> 5, l31 = lane & 31, f = (lane >> 1) & 7;
    const int lr = t >> 3, lc = t & 7;
    const int wofs = lr * 128 + ((lc ^ ((lr >> 1) & 7)) << 4);
    bf16_t* sq = slotp(P, SL_SQ); const bf16_t* sk = slotp(P, SL_SK); const bf16_t* svT = slotp(P, SL_SVT); const bf16_t* sz = slotp(P, SL_SZ);
    const int q0 = qt * 256 + 32 * w, qpos = q0 + l31;
    const size_t tokq = (size_t)b * kS + qpos;
    volatile int* flags = (volatile int*)(lds + 32768);
    bf16x8 qf[4];
#pragma unroll
    for (int ks = 0; ks < 4; ++ks) qf[ks] = *(const bf16x8*)(sq + tokq * 512 + hd * 64 + 16 * ks + 8 * h);
    f32x16 O[2]; O[0] = zero16(); O[1] = zero16();
    float R = 0.f; bool done = false;
    const bf16_t* kg = sk + ((size_t)b * kS + lr) * 512 + hd * 64 + lc * 8;
    const bf16_t* vg = svT + ((size_t)(b * 8 + hd) * 64 + lr) * kS + lc * 8;
    const int ktop = qt * 4 + 3;
    const int scd = ((lc ^ ((lr >> 1) & 7)) - lc) * 8;
    const bf16_t* kgs = kg + scd; const bf16_t* vgs = vg + scd;
    const int wb = w * 1024;
    __builtin_amdgcn_global_load_lds((const unsigned*)(kgs + (size_t)ktop * 64 * 512), (lds_ptr_t)(lds + wb), 16, 0, 0);
    __builtin_amdgcn_global_load_lds((const unsigned*)(vgs + ktop * 64), (lds_ptr_t)(lds + 8192 + wb), 16, 0, 0);
    asm volatile("s_waitcnt vmcnt(0)" ::: "memory");
    __syncthreads();
    for (int kt = ktop, it = 0; kt >= 0; --kt, ++it) {
        char* st = lds + (it & 1) * 16384;
        const bool more = kt > 0;
        if (more) {
            char* st2 = lds + ((it + 1) & 1) * 16384 + wb;
            __builtin_amdgcn_global_load_lds((const unsigned*)(kgs + (size_t)(kt - 1) * 64 * 512), (lds_ptr_t)(st2), 16, 0, 0);
            __builtin_amdgcn_global_load_lds((const unsigned*)(vgs + (kt - 1) * 64), (lds_ptr_t)(st2 + 8192), 16, 0, 0);
        }
        __builtin_amdgcn_sched_barrier(0);
        if (!done && kt * 64 < q0 + 31) {
            f32x16 Z[2];
#pragma unroll
            for (int kb = 0; kb < 2; ++kb) {
                Z[kb] = zero16();
#pragma unroll
                for (int ks = 0; ks < 4; ++ks) {
                    const bf16x8 kf = *(const bf16x8*)(st + (32 * kb + l31) * 128 + (((2 * ks + h) ^ f) << 4));
                    Z[kb] = MFMA(kf, qf[ks], Z[kb]);
                }
            }
            const bool diag = kt * 64 + 63 >= q0;
            float run = R;
#pragma unroll
            for (int kb = 1; kb >= 0; --kb) {
                float Lv[16];
                if (diag) {
#pragma unroll
                    for (int i = 0; i < 16; ++i) {
                        const float z = Z[kb][i];
                        const float sp = fmaxf(z, 0.f) + flog2(1.f + fexp2(-fabsf(z)));
                        const int key = kt * 64 + 32 * kb + (i & 3) + 8 * (i >> 2) + 4 * h;
                        const bool past = key < qpos;
                        Lv[i] = past ? -sp : 0.f;
                        Z[kb][i] = past ? z : -1e30f;
                    }
                } else {
#pragma unroll
                    for (int i = 0; i < 16; ++i) {
                        const float z = Z[kb][i];
                        Lv[i] = -(fmaxf(z, 0.f) + flog2(1.f + fexp2(-fabsf(z))));
                    }
                }
                float cs[4], ps[4];
#pragma unroll
                for (int g = 0; g < 4; ++g) { cs[g] = (Lv[4 * g] + Lv[4 * g + 1]) + (Lv[4 * g + 2] + Lv[4 * g + 3]); ps[g] = __shfl_xor(cs[g], 32); }
#pragma unroll
                for (int g = 3; g >= 0; --g) {
                    const float off = run + (h == 0 ? ps[g] : 0.f);
                    const float l3 = off, l2 = l3 + Lv[4 * g + 3], l1 = l2 + Lv[4 * g + 2], l0 = l1 + Lv[4 * g + 1];
                    Z[kb][4 * g + 3] = fexp2(Z[kb][4 * g + 3] + Lv[4 * g + 3] + l3);
                    Z[kb][4 * g + 2] = fexp2(Z[kb][4 * g + 2] + Lv[4 * g + 2] + l2);
                    Z[kb][4 * g + 1] = fexp2(Z[kb][4 * g + 1] + Lv[4 * g + 1] + l1);
                    Z[kb][4 * g + 0] = fexp2(Z[kb][4 * g + 0] + Lv[4 * g + 0] + l0);
                    run += cs[g] + ps[g];
                }
            }
            R = run;
            bf16x8 pf[4];
            pf[0] = pack8(Z[0], 0); pf[1] = pack8(Z[0], 1); pf[2] = pack8(Z[1], 0); pf[3] = pack8(Z[1], 1);
#pragma unroll
            for (int s = 0; s < 4; ++s)
#pragma unroll
                for (int db = 0; db < 2; ++db) {
                    const bf16x8 vf = *(const bf16x8*)(st + 8192 + (32 * db + l31) * 128 + (((2 * s + h) ^ f) << 4));
                    O[db] = MFMA(vf, pf[s], O[db]);
                }
            done = __all(R < kSbExit) != 0;
        }
        if (lane == 0) flags[(it & 1) * 8 + w] = done ? 1 : 0;
        asm volatile("s_waitcnt vmcnt(0)" ::: "memory");
        __syncthreads();
        int alld = 1;
#pragma unroll
        for (int i = 0; i < 8; ++i) alld &= flags[(it & 1) * 8 + i];
        if (alld) break;
    }
#pragma unroll
    for (int db = 0; db < 2; ++db)
#pragma unroll
        for (int p2 = 0; p2 < 2; ++p2) {
            unsigned ov[2][2];
#pragma unroll
            for (int e = 0; e < 2; ++e) {
                const int q4 = 2 * p2 + e, dv = 32 * db + 8 * q4 + 4 * h;
                const u32x2 z2 = *(const u32x2*)(sz + tokq * 512 + hd * 64 + dv);
                ov[e][0] = pk2(O[db][4 * q4] * bf_lo(z2[0]), O[db][4 * q4 + 1] * bf_hi(z2[0]));
                ov[e][1] = pk2(O[db][4 * q4 + 2] * bf_lo(z2[1]), O[db][4 * q4 + 3] * bf_hi(z2[1]));
            }
            swap32(ov[0][0], ov[1][0]); swap32(ov[0][1], ov[1][1]);
            u32x4 o = {ov[0][0], ov[0][1], ov[1][0], ov[1][1]};
            *(u32x4*)(sq + tokq * 512 + hd * 64 + 32 * db + 16 * p2 + 8 * h) = o;
        }
    __syncthreads();
}

DI void attn_phase(const Params& P, int layer, char* lds) {
    conv_pass(P, layer);
    const int lane = tid() & 63;
    float a1 = P.lq1[layer * 64 + lane] * P.lk1[layer * 64 + lane], a2 = P.lq2[layer * 64 + lane] * P.lk2[layer * 64 + lane];
    float mq = fabsf(P.dqn[layer * 64 + lane]), mk = fabsf(P.dkn[layer * 64 + lane]);
#pragma unroll
    for (int o = 32; o >= 1; o >>= 1) { a1 += __shfl_xor(a1, o); a2 += __shfl_xor(a2, o); mq = fmaxf(mq, __shfl_xor(mq, o)); mk = fmaxf(mk, __shfl_xor(mk, o)); }
    const float lam_init = 0.8f - 0.6f * __expf(-0.3f * (float)layer);
    const float lam = __expf(a1) - __expf(a2) + lam_init;
    const float negM2 = -(8.f * mq * mk * kLog2e);
    for (int i = blockIdx.x; i < 256; i += gridDim.x) {
        const int x = i & 7, j = i >> 3, bh = x * 2 + (j >> 4), pr = j & 15;
#pragma unroll 1
        for (int e = 0; e < 2; ++e) diff_item(P, layer, bh >> 2, bh & 3, e ? pr : 31 - pr, lam, 1.f - lam_init, negM2, lds);
    }
    for (int i = blockIdx.x; i < 1024; i += gridDim.x) {
        const int x = i & 7, j = i >> 3, bh = x * 4 + (j >> 5), qt = j & 31;
        sb_item(P, bh >> 3, bh & 7, qt, lds);
    }
}

DI unsigned q8(float g) { return (unsigned)(g * 255.f + 0.5f); }
DI unsigned q8x4(float a, float b, float c, float d) { return q8(a) | (q8(b) << 8) | (q8(c) << 16) | (q8(d) << 24); }
DI float dq8(unsigned w, int k) { return (float)((w >> (8 * k)) & 255u) * (1.f / 255.f); }
DI u32x4* gate_slot(const Params& P, int tile, int j, int g8) { return (u32x4*)slotp(P, SL_SK) + ((size_t)(tile * 3 + j) * 8 + g8) * 512 + tid(); }

DI void gate_epilogue(const Params& P, int layer, int j, const f32x4 (&acc)[2][2][4][2], int tile, int n0, const char* lds) {
    LANE_DECODE; (void)lane;
    const float* rsl = (const float*)(lds + LDS_RS);
#pragma unroll
    for (int ai = 0; ai < 2; ++ai) {
        const int col = n0 + ai * 128 + wr * 64 + 8 * fq;
        const float* bg = P.b_gate + layer * 3072 + j * 1024 + col;
        const f32x4 b0 = *(const f32x4*)bg, b1 = *(const f32x4*)(bg + 4), b2 = *(const f32x4*)(bg + 32), b3 = *(const f32x4*)(bg + 36);
#pragma unroll
        for (int bj = 0; bj < 2; ++bj)
#pragma unroll
            for (int nn = 0; nn < 2; ++nn) {
                const int rl = bj * 128 + wc * 32 + nn * 16 + fr;
                float lo[8], hi[8];
                grp16(acc, ai, bj, nn, rsl[rl], lo, hi);
#pragma unroll
                for (int i = 0; i < 4; ++i) { lo[i] = sigm(lo[i] + b0[i]); lo[4 + i] = sigm(lo[4 + i] + b1[i]); hi[i] = sigm(hi[i] + b2[i]); hi[4 + i] = sigm(hi[4 + i] + b3[i]); }
                u32x4 o = {q8x4(lo[0], lo[1], lo[2], lo[3]), q8x4(lo[4], lo[5], lo[6], lo[7]), q8x4(hi[0], hi[1], hi[2], hi[3]), q8x4(hi[4], hi[5], hi[6], hi[7])};
                *gate_slot(P, tile, j, ai * 4 + bj * 2 + nn) = o;
                __builtin_amdgcn_sched_barrier(0);
            }
    }
}

DI void y_epilogue(const Params& P, int j, bf16_t* __restrict__ hb, const f32x4 (&acc)[2][2][4][2], int tile, int m0, int n0) {
    LANE_DECODE; (void)lane;
#pragma unroll
    for (int ai = 0; ai < 2; ++ai)
#pragma unroll
        for (int bj = 0; bj < 2; ++bj)
#pragma unroll
            for (int nn = 0; nn < 2; ++nn) {
                const size_t tok = (size_t)m0 + bj * 128 + wc * 32 + nn * 16 + fr;
                const int col = n0 + ai * 128 + wr * 64 + 8 * fq;
                float lo[8], hi[8];
                grp16(acc, ai, bj, nn, 1.f, lo, hi);
                const u32x4 gq = *gate_slot(P, tile, j, ai * 4 + bj * 2 + nn);
                bf16_t* hp = hb + tok * 1024 + col;
                u32x4 h0 = {0u, 0u, 0u, 0u}, h1 = {0u, 0u, 0u, 0u};
                if (j > 0) { h0 = *(const u32x4*)hp; h1 = *(const u32x4*)(hp + 32); }
                u32x4 o0, o1;
#pragma unroll
                for (int i = 0; i < 4; ++i) {
                    o0[i] = pk2(bf_lo(h0[i]) + dq8(gq[i >> 1], 2 * (i & 1)) * lo[2 * i], bf_hi(h0[i]) + dq8(gq[i >> 1], 2 * (i & 1) + 1) * lo[2 * i + 1]);
                    o1[i] = pk2(bf_lo(h1[i]) + dq8(gq[2 + (i >> 1)], 2 * (i & 1)) * hi[2 * i], bf_hi(h1[i]) + dq8(gq[2 + (i >> 1)], 2 * (i & 1) + 1) * hi[2 * i + 1]);
                }
                *(u32x4*)hp = o0; *(u32x4*)(hp + 32) = o1;
                __builtin_amdgcn_sched_barrier(0);
            }
}

DI void merge_phase(const Params& P, int layer, char* lds) {
    const bf16_t* xb = (const bf16_t*)(P.ws + ((layer & 1) ? OFF_HB : OFF_XN));
    bf16_t* hb = (bf16_t*)(P.ws + ((layer & 1) ? OFF_XN : OFF_HB));
    const float* ssq = (const float*)(P.ws + OFF_SSQA);
    for (int t = blockIdx.x; t < 128 * 4; t += gridDim.x) {
        int mt, nt; tile_map(t, mt, nt);
        const int m0 = mt * 256, n0 = nt * 256;
        tile_rstd(ssq, m0, lds);
#pragma unroll 1
        for (int j = 0; j < 3; ++j) {
            f32x4 acc[2][2][4][2];
            gemm8(acc, wtp(P, layer, W_G) + (size_t)(j * 1024 + n0) * 1024, xb + (size_t)m0 * 1024, 1024, lds);
            __syncthreads();
            gate_epilogue(P, layer, j, acc, t, n0, lds);
            const bf16_t* Aj = slotp(P, j == 0 ? SL_BZ : (j == 1 ? SL_SQ : SL_DQ));
            const bf16_t* Wj = wtp(P, layer, j == 0 ? W_OC : (j == 1 ? W_OSB : W_OD));
            gemm8(acc, Wj + (size_t)n0 * 512, Aj + (size_t)m0 * 512, 512, lds);
            y_epilogue(P, j, hb, acc, t, m0, n0);
        }
    }
    p_to_bf16(P.p + (size_t)layer * kT * 256, slotp(P, SL_CU));
}

template <bool XBF, bool WF32>
DI void resid_epilogue(const float* __restrict__ xs, const bf16_t* __restrict__ xsb, float* __restrict__ out, bf16_t* __restrict__ xbn, float* __restrict__ ssq,
                       const f32x4 (&acc)[2][2][4][2], int m0, int n0, int nt, bool wxb = true) {
    LANE_DECODE; (void)lane;
#pragma unroll
    for (int bj = 0; bj < 2; ++bj)
#pragma unroll
        for (int nn = 0; nn < 2; ++nn) {
            const size_t tok = (size_t)m0 + bj * 128 + wc * 32 + nn * 16 + fr;
            float ss = 0.f;
#pragma unroll
            for (int ai = 0; ai < 2; ++ai) {
                float lo[8], hi[8];
                grp16(acc, ai, bj, nn, 1.f, lo, hi);
                const size_t o = tok * 1024 + n0 + ai * 128 + wr * 64 + 8 * fq;
                if (XBF) {
                    const u32x4 xl = *(const u32x4*)(xsb + o), xh = *(const u32x4*)(xsb + o + 32);
#pragma unroll
                    for (int j = 0; j < 4; ++j) { lo[2 * j] += bf_lo(xl[j]); lo[2 * j + 1] += bf_hi(xl[j]); hi[2 * j] += bf_lo(xh[j]); hi[2 * j + 1] += bf_hi(xh[j]); }
                } else {
#pragma unroll
                    for (int q4 = 0; q4 < 2; ++q4) {
                        const f32x4 xl = *(const f32x4*)(xs + o + 4 * q4), xh = *(const f32x4*)(xs + o + 32 + 4 * q4);
#pragma unroll
                        for (int j = 0; j < 4; ++j) { lo[4 * q4 + j] += xl[j]; hi[4 * q4 + j] += xh[j]; }
                    }
                }
#pragma unroll
                for (int i = 0; i < 8; ++i) ss += lo[i] * lo[i] + hi[i] * hi[i];
                if (WF32) {
#pragma unroll
                    for (int q4 = 0; q4 < 2; ++q4) {
                        *(f32x4*)(out + o + 4 * q4) = (f32x4){lo[4 * q4], lo[4 * q4 + 1], lo[4 * q4 + 2], lo[4 * q4 + 3]};
                        *(f32x4*)(out + o + 32 + 4 * q4) = (f32x4){hi[4 * q4], hi[4 * q4 + 1], hi[4 * q4 + 2], hi[4 * q4 + 3]};
                    }
                }
                if (wxb) { st8(xbn + o, lo); st8(xbn + o + 32, hi); }
            }
            ss += __shfl_xor(ss, 16); ss += __shfl_xor(ss, 32);
            if (wxb && fq < 2) ssq[tok * 16 + 4 * nt + 2 * fq + wr] = fq == 0 ? ss : 0.f;
            __builtin_amdgcn_sched_barrier(0);
        }
}

DI void wout_phase(const Params& P, int layer, char* lds) {
    const bf16_t* hb = (const bf16_t*)(P.ws + ((layer & 1) ? OFF_XN : OFF_HB));
    bf16_t* xb2 = (bf16_t*)(P.ws + ((layer & 1) ? OFF_HB : OFF_XN));
    const float* xs = layer == 0 ? P.x : P.out;
    for (int t = blockIdx.x; t < 128 * 4; t += gridDim.x) {
        int mt, nt; tile_map(t, mt, nt);
        const int m0 = mt * 256, n0 = nt * 256;
        f32x4 acc[2][2][4][2];
        gemm8(acc, wtp(P, layer, W_OUT) + (size_t)n0 * 1024, hb + (size_t)m0 * 1024, 1024, lds);
        resid_epilogue<false, false>(xs, nullptr, nullptr, xb2, (float*)(P.ws + OFF_SSQB), acc, m0, n0, nt);
    }
}

DI u32x4* ple_slot(const Params& P, int tile, int g8) { return (u32x4*)slotp(P, SL_SQ) + ((size_t)tile * 8 + g8) * 512 + tid(); }

DI void ple_gate_store(const Params& P, const f32x4 (&acc)[2][2][4][2], int tile, const char* lds) {
    LANE_DECODE; (void)lane; (void)wr; (void)fq;
    const float* rsl = (const float*)(lds + LDS_RS);
#pragma unroll
    for (int ai = 0; ai < 2; ++ai)
#pragma unroll
        for (int bj = 0; bj < 2; ++bj)
#pragma unroll
            for (int nn = 0; nn < 2; ++nn) {
                float lo[8], hi[8];
                grp16(acc, ai, bj, nn, rsl[bj * 128 + wc * 32 + nn * 16 + fr], lo, hi);
#pragma unroll
                for (int i = 0; i < 8; ++i) { lo[i] = sigm(lo[i]); hi[i] = sigm(hi[i]); }
                u32x4 o = {q8x4(lo[0], lo[1], lo[2], lo[3]), q8x4(lo[4], lo[5], lo[6], lo[7]), q8x4(hi[0], hi[1], hi[2], hi[3]), q8x4(hi[4], hi[5], hi[6], hi[7])};
                *ple_slot(P, tile, ai * 4 + bj * 2 + nn) = o;
                __builtin_amdgcn_sched_barrier(0);
            }
}

DI void ple_gate_apply(const Params& P, f32x4 (&acc)[2][2][4][2], int tile) {
#pragma unroll
    for (int ai = 0; ai < 2; ++ai)
#pragma unroll
        for (int bj = 0; bj < 2; ++bj)
#pragma unroll
            for (int nn = 0; nn < 2; ++nn) {
                const u32x4 gq = *ple_slot(P, tile, ai * 4 + bj * 2 + nn);
#pragma unroll
                for (int e = 0; e < 8; ++e) {
                    acc[ai][bj][e >> 2][nn][e & 3] *= dq8(gq[e >> 2], e & 3);
                    acc[ai][bj][2 + (e >> 2)][nn][e & 3] *= dq8(gq[2 + (e >> 2)], e & 3);
                }
                __builtin_amdgcn_sched_barrier(0);
            }
}

DI void ple_phase(const Params& P, int layer, char* lds) {
    const bf16_t* xb2 = (const bf16_t*)(P.ws + ((layer & 1) ? OFF_HB : OFF_XN));
    bf16_t* xb3 = (bf16_t*)(P.ws + ((layer & 1) ? OFF_XN : OFF_HB));
    const bf16_t* pb = slotp(P, SL_CU);
    for (int t = blockIdx.x; t < 128 * 4; t += gridDim.x) {
        int mt, nt; tile_map(t, mt, nt);
        const int m0 = mt * 256, n0 = nt * 256;
        tile_rstd((const float*)(P.ws + OFF_SSQB), m0, lds);
        f32x4 acc[2][2][4][2];
        gemm8(acc, wtp(P, layer, W_PG) + (size_t)n0 * 1024, xb2 + (size_t)m0 * 1024, 1024, lds);
        __syncthreads();
        ple_gate_store(P, acc, t, lds);
        gemm8(acc, wtp(P, layer, W_PLE) + (size_t)n0 * 256, pb + (size_t)m0 * 256, 256, lds);
        ple_gate_apply(P, acc, t);
        resid_epilogue<true, true>(nullptr, xb2, P.out, xb3, (float*)(P.ws + OFF_SSQA), acc, m0, n0, nt, layer == 0);
    }
}

DI void prologue_phase(const Params& P, char* lds) {
    for (int l = 0; l < 2; ++l) {
        convert_job(P.w_in + (size_t)l * 1024 * 9216, 9216, 1024, 6144, 1, 0, P.norm_w + l * 1024, wtp(P, l, W_IN), lds);
        convert_job(P.w_in + (size_t)l * 1024 * 9216, 9216, 1024, 3072, 0, 6144, P.norm_w + l * 1024, wtp(P, l, W_G), lds);
        convert_job(P.w_oc + (size_t)l * 512 * 1024, 1024, 512, 1024, 0, 0, nullptr, wtp(P, l, W_OC), lds);
        convert_job(P.w_osb + (size_t)l * 512 * 1024, 1024, 512, 1024, 0, 0, nullptr, wtp(P, l, W_OSB), lds);
        convert_job(P.w_od + (size_t)l * 512 * 1024, 1024, 512, 1024, 0, 0, nullptr, wtp(P, l, W_OD), lds);
        convert_job(P.w_out + (size_t)l * 1024 * 1024, 1024, 1024, 1024, 0, 0, nullptr, wtp(P, l, W_OUT), lds);
        convert_job(P.w_pg + (size_t)l * 1024 * 1024, 1024, 1024, 1024, 0, 0, P.ple_norm + l * 1024, wtp(P, l, W_PG), lds);
        convert_job(P.w_ple + (size_t)l * 256 * 1024, 1024, 256, 1024, 0, 0, nullptr, wtp(P, l, W_PLE), lds);
    }
    rope_tables(P);
    x_to_bf16_ssq(P.x, (bf16_t*)(P.ws + OFF_XN), (float*)(P.ws + OFF_SSQA));
}

constexpr int kNumPhases = 11;
DI void run_phase(const Params& P, int ph, char* lds) {
    if (ph == 0) { prologue_phase(P, lds); return; }
    const int layer = (ph - 1) / 5, s = (ph - 1) % 5;
    switch (s) {
        case 0: inproj_phase(P, layer, lds); break;
        case 1: attn_phase(P, layer, lds); break;
        case 2: merge_phase(P, layer, lds); break;
        case 3: wout_phase(P, layer, lds); break;
        default: ple_phase(P, layer, lds); break;
    }
}


#define XB_TMO      128
#define XB_XCNT(j)  (256  + 64 * (j))
#define XB_XSUB(j)  (1280 + 64 * (j))
#define XB_XGEN(j)  (2304 + 64 * (j))
#define XB_TOP      3328
#define XB_TOPGEN   3392
#define XCD_BAR_WORDS 3456
#define XB_SPIN_CAP (1u << 22)
#define LAS __attribute__((address_space(3)))
DI unsigned xb_ld(unsigned* p) { return __hip_atomic_load(p, __ATOMIC_RELAXED, __HIP_MEMORY_SCOPE_AGENT); }
DI unsigned xb_add(unsigned* p, unsigned v) { return __hip_atomic_fetch_add(p, v, __ATOMIC_RELAXED, __HIP_MEMORY_SCOPE_AGENT); }
DI unsigned xb_xcc_id() { return (unsigned)__builtin_amdgcn_s_getreg((3 << 11) | 20) & 0xFu; }
#define XB_SPIN(cond, bar) do { unsigned _sp = 0; while (cond) { __builtin_amdgcn_s_sleep(1); \
    if ((++_sp & 255u) == 0u) { if (xb_ld(&(bar)[XB_TMO])) break; if (_sp > XB_SPIN_CAP) { atomicAdd(&(bar)[XB_TMO], 1u); break; } } } } while (0)
struct XcdBarrier { unsigned* bar; unsigned x; volatile LAS unsigned* st; };
DI XcdBarrier xcd_barrier_post(unsigned* bar, volatile LAS unsigned* st) {
    XcdBarrier b; b.bar = bar; b.x = xb_xcc_id(); b.st = st;
    if (threadIdx.x == 0) (void)xb_add(&bar[XB_XCNT(b.x)], 1u);
    return b;
}
DI void xcd_barrier_complete(unsigned* bar, unsigned x, unsigned& nloc, unsigned& nx) {
    const unsigned G = gridDim.x * gridDim.y * gridDim.z;
    unsigned sum, cnt, mine, sp = 0u;
    for (;;) {
        sum = 0u; cnt = 0u; mine = 0u;
#pragma unroll
        for (unsigned j = 0; j < 16; ++j) { const unsigned c = xb_ld(&bar[XB_XCNT(j)]); sum += c; cnt += (c > 0u) ? 1u : 0u; mine = (j == x) ? c : mine; }
        if (sum == G) break;
        __builtin_amdgcn_s_sleep(1);
        if ((++sp & 255u) == 0u) { if (xb_ld(&bar[XB_TMO])) break; if (sp > XB_SPIN_CAP) { atomicAdd(&bar[XB_TMO], 1u); break; } }
    }
    nloc = mine > 0u ? mine : 1u; nx = cnt > 0u ? cnt : 1u;
}
DI void xcd_barrier(const XcdBarrier& b) {
    asm volatile("s_waitcnt vmcnt(0)" ::: "memory");
    __syncthreads();
    if (threadIdx.x == 0) {
        unsigned* bar = b.bar;
        __builtin_amdgcn_s_waitcnt(0);
        unsigned nloc = b.st[0], nx = b.st[1];
        if (nloc == 0u) { xcd_barrier_complete(bar, b.x, nloc, nx); b.st[0] = nloc; b.st[1] = nx; }
        const unsigned old = xb_add(&bar[XB_XSUB(b.x)], 1u);
        const unsigned gen = old / nloc;
        if (old + 1u == (gen + 1u) * nloc) {
            __builtin_amdgcn_fence(__ATOMIC_RELEASE, "agent");
            asm volatile("s_waitcnt vmcnt(0)" ::: "memory");
            const unsigned og = xb_add(&bar[XB_TOP], 1u);
            const unsigned tg = og / nx;
            if (og + 1u == (tg + 1u) * nx) xb_add(&bar[XB_TOPGEN], 1u);
            else XB_SPIN(xb_ld(&bar[XB_TOPGEN]) == tg, bar);
            __builtin_amdgcn_fence(__ATOMIC_ACQUIRE, "agent");
            xb_add(&bar[XB_XGEN(b.x)], 1u);
            asm volatile("s_waitcnt vmcnt(0)" ::: "memory");
        } else {
            XB_SPIN(xb_ld(&bar[XB_XGEN(b.x)]) == gen, bar);
            __builtin_amdgcn_fence(__ATOMIC_ACQUIRE, "agent");
            asm volatile("s_waitcnt vmcnt(0)" ::: "memory");
        }
    }
    __syncthreads();
}

__global__ void __launch_bounds__(512) fwd_megakernel(Params P) {
    __shared__ __attribute__((aligned(16))) char smem[LDS_BYTES];
    unsigned* bar = (unsigned*)(P.ws + OFF_BAR);
    volatile LAS unsigned* xst = (volatile LAS unsigned*)(smem + LDS_XB);
    if (threadIdx.x < 4) xst[threadIdx.x] = 0u;
    if (blockIdx.x == 0) for (int i = threadIdx.x; i < XCD_BAR_WORDS; i += 512) bar[i] = 0u;
    __syncthreads();
    for (int ph = P.ph_lo; ph < P.ph_hi; ++ph) {
        run_phase(P, ph, smem);
        if (ph + 1 < P.ph_hi) {
            if (ph == P.ph_lo) { cg::this_grid().sync(); (void)xcd_barrier_post((unsigned*)(P.ws + OFF_BAR), (volatile LAS unsigned*)(smem + LDS_XB)); }
            else { XcdBarrier xb; xb.bar = (unsigned*)(P.ws + OFF_BAR); xb.x = xb_xcc_id(); xb.st = (volatile LAS unsigned*)(smem + LDS_XB); xcd_barrier(xb); }
        }
    }
}

extern "C" void kernel_launch(void* const* d_in, const int* in_sizes, int n_in, void* d_out, int out_size, void* d_ws, size_t ws_size,
                              hipStream_t stream) {
    if (ws_size < WS_NEED) { fprintf(stderr, "workspace too small: %zu < %zu\n", ws_size, (size_t)WS_NEED); return; }
    Params P{};
    P.x = (const float*)d_in[0]; P.p = (const float*)d_in[1]; P.norm_w = (const float*)d_in[2]; P.w_in = (const float*)d_in[3];
    P.b_gate = (const float*)d_in[4]; P.conv_w = (const float*)d_in[5]; P.dqn = (const float*)d_in[6]; P.dkn = (const float*)d_in[7];
    P.lq1 = (const float*)d_in[8]; P.lk1 = (const float*)d_in[9]; P.lq2 = (const float*)d_in[10]; P.lk2 = (const float*)d_in[11];
    P.subln = (const float*)d_in[12]; P.w_oc = (const float*)d_in[13]; P.w_osb = (const float*)d_in[14]; P.w_od = (const float*)d_in[15];
    P.w_out = (const float*)d_in[16]; P.ple_norm = (const float*)d_in[17]; P.w_pg = (const float*)d_in[18]; P.w_ple = (const float*)d_in[19];
    P.out = (float*)d_out; P.ws = (char*)d_ws;
#if MK_MULTI
    for (int ph = 0; ph < kNumPhases; ++ph) {
        P.ph_lo = ph; P.ph_hi = ph + 1;
        hipLaunchKernelGGL(fwd_megakernel, dim3(256), dim3(512), 0, stream, P);
    }
#else
    static int grid_blocks = 0;
    if (!grid_blocks) {
        int dev = 0, cus = 0, per_cu = 0;
        (void)hipGetDevice(&dev);
        (void)hipDeviceGetAttribute(&cus, hipDeviceAttributeMultiprocessorCount, dev);
        (void)hipOccupancyMaxActiveBlocksPerMultiprocessor(&per_cu, fwd_megakernel, 512, 0);
        if (per_cu < 1) per_cu = 1;
        if (per_cu > 1) per_cu = 1;
        grid_blocks = cus * per_cu;
    }
    P.ph_lo = 0; P.ph_hi = kNumPhases;
    void* args[] = {&P};
    hipError_t e = hipLaunchCooperativeKernel((void*)fwd_megakernel, dim3(grid_blocks), dim3(512), args, 0, stream);
    if (e != hipSuccess) fprintf(stderr, "cooperative launch failed: %s (grid %d)\n", hipGetErrorString(e), grid_blocks);
#endif
}
```

```cpp
#include <hip/hip_runtime.h>
#include <hip/hip_cooperative_groups.h>
#include <cstdio>
#include <cstdint>
namespace cg = cooperative_groups;

#ifndef MK_MULTI
#define MK_MULTI 0
#endif
#ifndef PROBE_DUP
#define PROBE_DUP -1
#endif

typedef unsigned short bf16_t;
typedef short bf16x8 __attribute__((ext_vector_type(8)));
typedef float f32x16 __attribute__((ext_vector_type(16)));
typedef float f32x4 __attribute__((ext_vector_type(4)));
typedef float f32x2 __attribute__((ext_vector_type(2)));
typedef unsigned u32x4 __attribute__((ext_vector_type(4)));
typedef unsigned u32x2 __attribute__((ext_vector_type(2)));
typedef __bf16 bf2_t __attribute__((ext_vector_type(2)));
#define DI __device__ __forceinline__
#define MFMA(a, b, c) __builtin_amdgcn_mfma_f32_32x32x16_bf16((a), (b), (c), 0, 0, 0)

constexpr int kB = 4, kS = 8192, kT = kB * kS;
constexpr float kEps = 1e-6f;
constexpr float kLog2e = 1.4426950408889634f;
constexpr float kLn2 = 0.6931471805599453f;
constexpr size_t MiB = 1u << 20;
constexpr size_t OFF_COS = 0, OFF_SIN = 1 * MiB, OFF_WT = 4 * MiB, OFF_XN = 56 * MiB, OFF_HB = 120 * MiB, OFF_PROJ = 184 * MiB;
constexpr size_t PROJ_SLOT = 32 * MiB;
constexpr size_t OFF_SSQA = 2 * MiB, OFF_SSQB = 504 * MiB, OFF_BAR = 506 * MiB;
constexpr size_t WS_NEED = 507 * MiB;
enum { SL_CU = 0, SL_BZ = 1, SL_SQ = 2, SL_DQ = 3, SL_SK = 4, SL_SVT = 5, SL_SZ = 6, SL_DK = 7, SL_DVT = 8, SL_DZ = 9 };
constexpr int LDS_RS = 131072;
constexpr size_t W_IN = 0, W_G = W_IN + 6144 * 1024, W_OC = W_G + 3072 * 1024, W_OSB = W_OC + 512 * 1024, W_OD = W_OSB + 512 * 1024,
                 W_OUT = W_OD + 512 * 1024, W_PG = W_OUT + 1024 * 1024, W_PLE = W_PG + 1024 * 1024, W_LAYER = W_PLE + 256 * 1024;
constexpr int LDS_XB = 132096;
constexpr int LDS_BYTES = 133120;

struct Params {
    const float* x; const float* p; const float* norm_w; const float* w_in; const float* b_gate; const float* conv_w;
    const float* dqn; const float* dkn; const float* lq1; const float* lk1; const float* lq2; const float* lk2;
    const float* subln; const float* w_oc; const float* w_osb; const float* w_od; const float* w_out; const float* ple_norm;
    const float* w_pg; const float* w_ple;
    float* out; char* ws;
    int ph_lo, ph_hi;
};

DI int tid() { int t = __builtin_amdgcn_workitem_id_x(); asm volatile("" : "+v"(t)); return t; }
DI unsigned pk2(float a, float b) { f32x2 v = {a, b}; return __builtin_bit_cast(unsigned, __builtin_convertvector(v, bf2_t)); }
DI float bf_lo(unsigned u) { return __uint_as_float(u << 16); }
DI float bf_hi(unsigned u) { return __uint_as_float(u & 0xffff0000u); }
DI float fexp2(float x) { return __builtin_amdgcn_exp2f(x); }
DI float flog2(float x) { return __builtin_amdgcn_logf(x); }
DI float frcp(float x) { return __builtin_amdgcn_rcpf(x); }
DI float sigm(float x) { return frcp(1.f + fexp2(-kLog2e * x)); }
DI float silu(float x) { return x * sigm(x); }
DI bf16_t* slotp(const Params& P, int s) { return (bf16_t*)(P.ws + OFF_PROJ + (size_t)s * PROJ_SLOT); }
DI bf16_t* wtp(const Params& P, int layer, size_t off) { return (bf16_t*)(P.ws + OFF_WT) + (size_t)layer * W_LAYER + off; }

DI void st16(bf16_t* dst, const f32x16& v) {
    u32x4 a = {pk2(v[0], v[1]), pk2(v[2], v[3]), pk2(v[4], v[5]), pk2(v[6], v[7])};
    u32x4 b = {pk2(v[8], v[9]), pk2(v[10], v[11]), pk2(v[12], v[13]), pk2(v[14], v[15])};
    *(u32x4*)dst = a; *(u32x4*)(dst + 8) = b;
}
DI f32x16 zero16() { f32x16 z; for (int i = 0; i < 16; ++i) z[i] = 0.f; return z; }
DI f32x16 splat16(float v) { f32x16 z; for (int i = 0; i < 16; ++i) z[i] = v; return z; }

typedef __attribute__((address_space(3))) void* lds_ptr_t;
#define MFMA16(a, b, c) __builtin_amdgcn_mfma_f32_16x16x32_bf16((a), (b), (c), 0, 0, 0)
DI int lds_byte(int r, int c) { const int st = (r >> 4) * 2 + (c >> 5), rr = r & 15, cc = c & 31, ob = rr * 64 + cc * 2; return st * 1024 + (ob ^ (((ob >> 9) & 1) << 5)); }
DI void stage_rc(int b, int& R, int& C) { const int st = b / 1024, sb = b % 1024, swz = sb ^ (((sb >> 9) & 1) << 5); R = (st >> 1) * 16 + swz / 64; C = (st & 1) * 32 + (swz % 64) / 2; }

DI void gemm8(f32x4 (&acc)[2][2][4][2], const bf16_t* __restrict__ Rm, const bf16_t* __restrict__ Cm, int K, char* shm) {
    constexpr int HT2 = 128 * 64 * 2;
    const int t = tid(), wid = t >> 6, lane = t & 63, wr = wid >> 2, wc = wid & 3, fr = lane & 15, fq = lane >> 4;
#define SA(b, hh) (shm + ((b) * 2 + (hh)) * HT2)
#define SB(b, hh) (shm + (4 + (b) * 2 + (hh)) * HT2)
    int gofs[2];
#pragma unroll
    for (int i = 0; i < 2; ++i) { int r_, c_; stage_rc(t * 16 + i * 8192, r_, c_); gofs[i] = r_ * K + c_; }
    const int wb = wid * 1024;
#define STAGE(P, BASE, br, kt) do { const bf16_t* g_ = (BASE) + (size_t)(br) * K + (size_t)(kt) * 64; \
        _Pragma("unroll") for (int i_ = 0; i_ < 2; ++i_) \
            __builtin_amdgcn_global_load_lds((const unsigned*)(g_ + gofs[i_]), (lds_ptr_t)((P) + wb + i_ * 8192), 16, 0, 0); } while (0)
#define LDA(dst, b, hh) _Pragma("unroll") for (int m = 0; m < 4; ++m) _Pragma("unroll") for (int k = 0; k < 2; ++k) \
        dst[m][k] = *(const bf16x8*)(SA(b, hh) + lds_byte(wr * 64 + m * 16 + fr, k * 32 + fq * 8))
#define LDB(dst, b, hh) _Pragma("unroll") for (int n = 0; n < 2; ++n) _Pragma("unroll") for (int k = 0; k < 2; ++k) \
        dst[n][k] = *(const bf16x8*)(SB(b, hh) + lds_byte(wc * 32 + n * 16 + fr, k * 32 + fq * 8))
#define MMA(ai, bj, At_, Bt_) do { __builtin_amdgcn_s_setprio(1); \
        _Pragma("unroll") for (int m = 0; m < 4; ++m) _Pragma("unroll") for (int n = 0; n < 2; ++n) _Pragma("unroll") for (int k = 0; k < 2; ++k) \
            acc[ai][bj][m][n] = MFMA16(At_[m][k], Bt_[n][k], acc[ai][bj][m][n]); \
        __builtin_amdgcn_s_setprio(0); } while (0)
#define WAIT_V(n) asm volatile("s_waitcnt vmcnt(" #n ")" ::: "memory")
#define WAIT_L(n) asm volatile("s_waitcnt lgkmcnt(" #n ")" ::: "memory")
#define BAR __builtin_amdgcn_s_barrier()
#define SCHED __builtin_amdgcn_sched_barrier(0)
#pragma unroll
    for (int a_ = 0; a_ < 2; ++a_)
#pragma unroll
        for (int b_ = 0; b_ < 2; ++b_)
#pragma unroll
            for (int m = 0; m < 4; ++m) { acc[a_][b_][m][0] = (f32x4){0.f, 0.f, 0.f, 0.f}; acc[a_][b_][m][1] = (f32x4){0.f, 0.f, 0.f, 0.f}; }
    bf16x8 At[4][2], B0[2][2], B1[2][2];
    const int nt = K >> 6;
    STAGE(SB(0, 0), Cm, 0, 0); STAGE(SA(0, 0), Rm, 0, 0);
    STAGE(SB(0, 1), Cm, 128, 0); STAGE(SA(0, 1), Rm, 128, 0);
    if (wr == 1) BAR;
    WAIT_V(4); BAR;
    STAGE(SB(1, 0), Cm, 0, 1); STAGE(SA(1, 0), Rm, 0, 1); STAGE(SB(1, 1), Cm, 128, 1);
    WAIT_V(6); BAR;
    for (int tt = 0; tt < nt - 2; tt += 2) {
        LDB(B0, 0, 0); SCHED; LDA(At, 0, 0); STAGE(SA(1, 1), Rm, 128, tt + 1);
        WAIT_L(8); BAR; WAIT_L(0); MMA(0, 0, At, B0); BAR; SCHED;
        LDB(B1, 0, 1); STAGE(SB(0, 0), Cm, 0, tt + 2);
        BAR; WAIT_L(0); MMA(0, 1, At, B1); BAR;
        LDA(At, 0, 1); STAGE(SA(0, 0), Rm, 0, tt + 2);
        BAR; WAIT_L(0); MMA(1, 0, At, B0); BAR; SCHED;
        STAGE(SB(0, 1), Cm, 128, tt + 2);
        WAIT_V(6); BAR; MMA(1, 1, At, B1); BAR;
        LDB(B0, 1, 0); SCHED; LDA(At, 1, 0); STAGE(SA(0, 1), Rm, 128, tt + 2);
        WAIT_L(8); BAR; WAIT_L(0); MMA(0, 0, At, B0); BAR; SCHED;
        LDB(B1, 1, 1); STAGE(SB(1, 0), Cm, 0, tt + 3);
        BAR; WAIT_L(0); MMA(0, 1, At, B1); BAR;
        LDA(At, 1, 1); STAGE(SA(1, 0), Rm, 0, tt + 3);
        BAR; WAIT_L(0); MMA(1, 0, At, B0); BAR; SCHED;
        STAGE(SB(1, 1), Cm, 128, tt + 3);
        WAIT_V(6); BAR; MMA(1, 1, At, B1); BAR;
    }
    { LDB(B0, 0, 0); LDA(At, 0, 0); STAGE(SA(1, 1), Rm, 128, nt - 1);
      BAR; WAIT_L(0); MMA(0, 0, At, B0); BAR;
      LDB(B1, 0, 1); BAR; WAIT_L(0); MMA(0, 1, At, B1); BAR;
      LDA(At, 0, 1); WAIT_V(4); BAR; WAIT_L(0); MMA(1, 0, At, B0); MMA(1, 1, At, B1); BAR; }
    { LDB(B0, 1, 0); LDA(At, 1, 0); WAIT_V(2); BAR; WAIT_L(0); MMA(0, 0, At, B0); BAR;
      LDB(B1, 1, 1); WAIT_V(0); BAR; WAIT_L(0); MMA(0, 1, At, B1); BAR;
      LDA(At, 1, 1); BAR; WAIT_L(0); MMA(1, 0, At, B0); MMA(1, 1, At, B1); BAR; }
    if (wr == 0) BAR;
#undef SA
#undef SB
#undef STAGE
#undef LDA
#undef LDB
#undef MMA
}

DI void grp16(const f32x4 (&acc)[2][2][4][2], int ai, int bj, int nn, float sc, float (&lo)[8], float (&hi)[8]) {
#pragma unroll
    for (int j = 0; j < 4; ++j) {
        lo[j] = acc[ai][bj][0][nn][j] * sc; lo[4 + j] = acc[ai][bj][1][nn][j] * sc;
        hi[j] = acc[ai][bj][2][nn][j] * sc; hi[4 + j] = acc[ai][bj][3][nn][j] * sc;
    }
}
DI void st8(bf16_t* dst, const float (&v)[8]) { u32x4 o = {pk2(v[0], v[1]), pk2(v[2], v[3]), pk2(v[4], v[5]), pk2(v[6], v[7])}; *(u32x4*)dst = o; }

DI void tile_map(int t, int& mt, int& nt) {
    const int round = t >> 8, b = t & 255, x = b & 7, j = b >> 3;
    const int rg = round & 1, cgp = round >> 1;
    mt = 64 * rg + 8 * x + (j & 7); nt = 4 * cgp + (j >> 3);
}

DI void tile_rstd(const float* __restrict__ ssq, int m0, char* lds) {
    __syncthreads();
    const int t = tid();
    if (t < 256) {
        const f32x4* p = (const f32x4*)(ssq + (size_t)(m0 + t) * 16);
        const f32x4 a = p[0], b = p[1], c = p[2], d = p[3];
        const float sm = ((a[0] + a[1]) + (a[2] + a[3])) + ((b[0] + b[1]) + (b[2] + b[3])) + ((c[0] + c[1]) + (c[2] + c[3])) + ((d[0] + d[1]) + (d[2] + d[3]));
        ((float*)(lds + LDS_RS))[t] = __builtin_amdgcn_rsqf(sm * (1.f / 1024.f) + kEps);
    }
}

DI int v2logical(int v) { const int m = (v >> 4) & 3, fq = (v >> 2) & 3, j = v & 3; return (v & ~63) + 32 * (m >> 1) + 8 * fq + 4 * (m & 1) + j; }
DI int inproj_actual(int L) {
    if (L < 1024) { const int i = L >> 8, w = L & 255; return (w < 128 ? 512 : 1024) + 128 * i + (w & 127); }
    if (L < 2048) { L -= 1024; const int i = L >> 8, w = L & 255; return (w < 128 ? 0 : 1536) + 128 * i + (w & 127); }
    return L;
}

DI void convert_job(const float* __restrict__ src, int ld, int K, int Nv, int mode, int coloff, const float* __restrict__ rowscale,
                    bf16_t* __restrict__ dst, char* lds) {
    float (*tl)[65] = (float (*)[65])lds;
    const int t = tid();
    const int tiles_k = K >> 6, tiles_v = Nv >> 6;
    for (int tile = blockIdx.x; tile < tiles_k * tiles_v; tile += gridDim.x) {
        const int tk = tile % tiles_k, tv = tile / tiles_k, k0 = tk * 64, v0 = tv * 64;
        {
            const int v = t & 63, kk = t >> 6;
            int L = v2logical(v0 + v);
            if (mode) { const int g = (v0 + v) >= 2048 ? ((v0 + v) - 2048) >> 9 : -1; if (g == 2 || g == 6) L = v0 + v; }
            const int col = mode ? inproj_actual(L) : coloff + L;
#pragma unroll
            for (int i = 0; i < 8; ++i) {
                const int k = kk + 8 * i;
                float xv = src[(size_t)(k0 + k) * ld + col];
                if (rowscale) xv *= rowscale[k0 + k];
                tl[k][v] = xv;
            }
        }
        __syncthreads();
        {
            const int vv = t >> 3, kc = t & 7;
            u32x4 o;
            o[0] = pk2(tl[8 * kc + 0][vv], tl[8 * kc + 1][vv]); o[1] = pk2(tl[8 * kc + 2][vv], tl[8 * kc + 3][vv]);
            o[2] = pk2(tl[8 * kc + 4][vv], tl[8 * kc + 5][vv]); o[3] = pk2(tl[8 * kc + 6][vv], tl[8 * kc + 7][vv]);
            *(u32x4*)(dst + (size_t)(v0 + vv) * K + k0 + 8 * kc) = o;
        }
        __syncthreads();
    }
}

DI void rope_tables(const Params& P) {
    float* ct = (float*)(P.ws + OFF_COS); float* sn = (float*)(P.ws + OFF_SIN);
    for (int idx = blockIdx.x * 512 + tid(); idx < kS * 32; idx += gridDim.x * 512) {
        const int pos = idx >> 5, i = idx & 31;
        const float inv = fexp2(-(float)i * (13.287712379549449f / 32.f));
        const float ang = (float)pos * inv;
        const double rev = (double)ang * 0.15915494309189535;
        const float fr = (float)(rev - floor(rev));
        ct[idx] = __builtin_amdgcn_cosf(fr); sn[idx] = __builtin_amdgcn_sinf(fr);
    }
}

DI void x_to_bf16_ssq(const float* __restrict__ src, bf16_t* __restrict__ dst, float* __restrict__ ssq) {
    const int lane = tid() & 63, wave = tid() >> 6;
    for (int row = blockIdx.x * 8 + wave; row < kT; row += gridDim.x * 8) {
        const f32x4* r = (const f32x4*)(src + (size_t)row * 1024);
        f32x4 v[4]; float ss = 0.f;
#pragma unroll
        for (int i = 0; i < 2; ++i) { v[2 * i] = r[2 * lane + 128 * i]; v[2 * i + 1] = r[2 * lane + 1 + 128 * i]; }
#pragma unroll
        for (int i = 0; i < 4; ++i) ss += v[i][0] * v[i][0] + v[i][1] * v[i][1] + v[i][2] * v[i][2] + v[i][3] * v[i][3];
#pragma unroll
        for (int o = 32; o >= 1; o >>= 1) ss += __shfl_xor(ss, o);
#pragma unroll
        for (int i = 0; i < 2; ++i) {
            u32x4 o = {pk2(v[2 * i][0], v[2 * i][1]), pk2(v[2 * i][2], v[2 * i][3]), pk2(v[2 * i + 1][0], v[2 * i + 1][1]), pk2(v[2 * i + 1][2], v[2 * i + 1][3])};
            *(u32x4*)(dst + (size_t)row * 1024 + 8 * lane + 512 * i) = o;
        }
        if (lane < 16) ssq[(size_t)row * 16 + lane] = lane == 0 ? ss : 0.f;
    }
}

DI void p_to_bf16(const float* __restrict__ src, bf16_t* __restrict__ dst) {
    const size_t n8 = (size_t)kT * 256 / 8;
    for (size_t i = (size_t)blockIdx.x * 512 + tid(); i < n8; i += (size_t)gridDim.x * 512) {
        const f32x4 a = ((const f32x4*)src)[2 * i], b = ((const f32x4*)src)[2 * i + 1];
        u32x4 o = {pk2(a[0], a[1]), pk2(a[2], a[3]), pk2(b[0], b[1]), pk2(b[2], b[3])};
        ((u32x4*)dst)[i] = o;
    }
}

#define LANE_DECODE const int t_ = tid(), wid = t_ >> 6, lane = t_ & 63, wr = wid >> 2, wc = wid & 3, fr = lane & 15, fq = lane >> 4

DI void inproj_epilogue(const Params& P, int layer, const f32x4 (&acc)[2][2][4][2], int m0, int n0, const char* lds) {
    LANE_DECODE; (void)lane;
    const float* rsl = (const float*)(lds + LDS_RS);
#pragma unroll
    for (int bj = 0; bj < 2; ++bj)
#pragma unroll
        for (int nn = 0; nn < 2; ++nn) {
            const int rl = bj * 128 + wc * 32 + nn * 16 + fr;
            const size_t tok = (size_t)m0 + rl;
            const float rr = rsl[rl];
            if (n0 < 2048) {
                float l0[8], h0[8], l1[8], h1[8];
                grp16(acc, 0, bj, nn, rr, l0, h0); grp16(acc, 1, bj, nn, rr, l1, h1);
                const bool iscu = n0 < 1024;
                const int ch = 128 * ((iscu ? n0 : n0 - 1024) >> 8) + 64 * wr + 8 * fq;
#pragma unroll
                for (int i = 0; i < 8; ++i) { l0[i] *= iscu ? l1[i] : silu(l1[i]); h0[i] *= iscu ? h1[i] : silu(h1[i]); }
                bf16_t* d = slotp(P, iscu ? SL_CU : SL_BZ) + tok * 512 + ch;
                st8(d, l0); st8(d + 32, h0);
            } else {
#pragma unroll
                for (int ai = 0; ai < 2; ++ai) {
                    const int ncol = n0 + ai * 128 + wr * 64;
                    const int grp = (ncol - 2048) >> 9, cin = (ncol - 2048) & 511;
                    float lo[8], hi[8];
                    grp16(acc, ai, bj, nn, rr, lo, hi);
                    if (grp == 0 || grp == 1) {
                        if (grp == 0) {
#pragma unroll
                            for (int i = 0; i < 8; ++i) { lo[i] *= 0.125f * kLog2e; hi[i] *= 0.125f * kLog2e; }
                        }
                        bf16_t* d = slotp(P, grp == 0 ? SL_SQ : SL_SK) + tok * 512 + cin + 8 * fq;
                        st8(d, lo); st8(d + 32, hi);
                    } else if (grp == 3 || grp == 7) {
#pragma unroll
                        for (int i = 0; i < 8; ++i) { lo[i] = silu(lo[i]); hi[i] = silu(hi[i]); }
                        bf16_t* d = slotp(P, grp == 3 ? SL_SZ : SL_DZ) + tok * 512 + cin + 8 * fq;
                        st8(d, lo); st8(d + 32, hi);
                    } else {
                        const float* wv = (grp == 4 ? P.dqn : P.dkn) + layer * 64;
                        float ss = 0.f;
#pragma unroll
                        for (int i = 0; i < 8; ++i) ss += lo[i] * lo[i] + hi[i] * hi[i];
                        ss += __shfl_xor(ss, 16); ss += __shfl_xor(ss, 32);
                        const float rs = __builtin_amdgcn_rsqf(ss * (1.f / 64.f) + kEps);
                        const float osc = grp == 4 ? 0.125f * kLog2e : 1.f;
                        const int pos = (int)(tok & (kS - 1));
                        const float* cp = (const float*)(P.ws + OFF_COS) + pos * 32 + 8 * fq;
                        const float* sp = (const float*)(P.ws + OFF_SIN) + pos * 32 + 8 * fq;
#pragma unroll
                        for (int q4 = 0; q4 < 2; ++q4) {
                            const f32x4 c4 = *(const f32x4*)(cp + 4 * q4), s4 = *(const f32x4*)(sp + 4 * q4);
                            const f32x4 w0 = *(const f32x4*)(wv + 8 * fq + 4 * q4), w1 = *(const f32x4*)(wv + 32 + 8 * fq + 4 * q4);
#pragma unroll
                            for (int j = 0; j < 4; ++j) {
                                const int i = 4 * q4 + j;
                                const float y0 = lo[i] * rs * w0[j], y1 = hi[i] * rs * w1[j];
                                lo[i] = (y0 * c4[j] - y1 * s4[j]) * osc; hi[i] = (y0 * s4[j] + y1 * c4[j]) * osc;
                            }
                        }
                        bf16_t* d = slotp(P, grp == 4 ? SL_DQ : SL_DK) + tok * 512 + cin + 8 * fq;
                        st8(d, lo); st8(d + 32, hi);
                    }
                }
            }
            __builtin_amdgcn_sched_barrier(0);
        }
}

DI void vT_epilogue(const Params& P, const f32x4 (&acc)[2][2][4][2], int m0, int n0, const char* lds) {
    LANE_DECODE; (void)lane;
    const float* rsl = (const float*)(lds + LDS_RS);
    const int grp = (n0 - 2048) >> 9;
#pragma unroll
    for (int ai = 0; ai < 2; ++ai)
#pragma unroll
        for (int m = 0; m < 4; ++m) {
            const int rb0 = ai * 128 + wr * 64 + m * 16;
            const int tb = m0 + rb0, b = tb / kS, pos0 = tb & (kS - 1);
            const f32x4 r4 = *(const f32x4*)(rsl + rb0 + 4 * fq);
            const int tp = 4 * (fq >> 1) + 8 * (fq & 1);
#pragma unroll
            for (int bj = 0; bj < 2; ++bj)
#pragma unroll
                for (int nn = 0; nn < 2; ++nn) {
                    const int cin = (n0 - 2048 + bj * 128 + wc * 32 + nn * 16 + fr) & 511;
                    bf16_t* rowp = grp == 2 ? slotp(P, SL_SVT) + ((size_t)(b * 8 + (cin >> 6)) * 64 + (cin & 63)) * kS + pos0
                                            : slotp(P, SL_DVT) + ((size_t)(b * 4 + (cin >> 7)) * 128 + (cin & 127)) * kS + pos0;
                    const f32x4 v = acc[ai][bj][m][nn];
                    u32x2 o = {pk2(v[0] * r4[0], v[1] * r4[1]), pk2(v[2] * r4[2], v[3] * r4[3])};
                    *(u32x2*)(rowp + tp) = o;
                }
        }
}

DI void inproj_phase(const Params& P, int layer, char* lds) {
    const bf16_t* xb = (const bf16_t*)(P.ws + ((layer & 1) ? OFF_HB : OFF_XN));
    const float* ssq = (const float*)(P.ws + OFF_SSQA);
    const bf16_t* wt = wtp(P, layer, W_IN);
    for (int t = blockIdx.x; t < 128 * 24; t += gridDim.x) {
        int mt, nt; tile_map(t, mt, nt);
        const int m0 = mt * 256, n0 = nt * 256;
        tile_rstd(ssq, m0, lds);
        f32x4 acc[2][2][4][2];
        const int grp = n0 >= 2048 ? (n0 - 2048) >> 9 : -1;
        if (grp == 2 || grp == 6) {
            gemm8(acc, xb + (size_t)m0 * 1024, wt + (size_t)n0 * 1024, 1024, lds);
            vT_epilogue(P, acc, m0, n0, lds);
        } else {
            gemm8(acc, wt + (size_t)n0 * 1024, xb + (size_t)m0 * 1024, 1024, lds);
            inproj_epilogue(P, layer, acc, m0, n0, lds);
        }
    }
}

DI void conv_pass(const Params& P, int layer) {
    const bf16_t* cu = slotp(P, SL_CU); bf16_t* bz = slotp(P, SL_BZ);
    const float* cw = P.conv_w + layer * 3 * 512;
    for (int idx = blockIdx.x * 512 + tid(); idx < kT * 64; idx += gridDim.x * 512) {
        const int tok = idx >> 6, c8 = (idx & 63) * 8, pos = tok & (kS - 1);
        const u32x4 z4 = {0u, 0u, 0u, 0u};
        const u32x4 c2 = *(const u32x4*)(cu + (size_t)tok * 512 + c8);
        const u32x4 c1 = pos >= 1 ? *(const u32x4*)(cu + (size_t)(tok - 1) * 512 + c8) : z4;
        const u32x4 c0 = pos >= 2 ? *(const u32x4*)(cu + (size_t)(tok - 2) * 512 + c8) : z4;
        const u32x4 bv = *(const u32x4*)(bz + (size_t)tok * 512 + c8);
        u32x4 o;
#pragma unroll
        for (int j = 0; j < 4; ++j) {
            const int ch = c8 + 2 * j;
            const float r0 = bf_lo(bv[j]) * (cw[ch] * bf_lo(c0[j]) + cw[512 + ch] * bf_lo(c1[j]) + cw[1024 + ch] * bf_lo(c2[j]));
            const float r1 = bf_hi(bv[j]) * (cw[ch + 1] * bf_hi(c0[j]) + cw[512 + ch + 1] * bf_hi(c1[j]) + cw[1024 + ch + 1] * bf_hi(c2[j]));
            o[j] = pk2(r0, r1);
        }
        *(u32x4*)(bz + (size_t)tok * 512 + c8) = o;
    }
}

DI bf16x8 pack8(const f32x16& v, int s) {
    u32x4 p = {pk2(v[8 * s], v[8 * s + 1]), pk2(v[8 * s + 2], v[8 * s + 3]), pk2(v[8 * s + 4], v[8 * s + 5]), pk2(v[8 * s + 6], v[8 * s + 7])};
    return __builtin_bit_cast(bf16x8, p);
}

DI void diff_pass(const bf16_t* __restrict__ qrow  , const bf16_t* __restrict__ kg, const bf16_t* __restrict__ vg,
                  int nkt, int q0, float negM2, f32x16 (&O)[4], float& lsum, char* lds) {
    const int t = tid(), lane = t & 63, wv = t >> 6, h = lane >> 5, l31 = lane & 31, f = (lane >> 1) & 7;
    const int lr = t >> 3, lc = t & 7;
    const int sc = (lc ^ ((lr >> 1) & 7)) - lc;
    const bf16_t* kgs = kg + sc * 8;
    const bf16_t* vgs = vg + sc * 8;
    const int wb = wv * 1024;
    const int qpos = q0 + l31;
    bf16x8 qf[4];
#pragma unroll
    for (int ks = 0; ks < 4; ++ks) qf[ks] = *(const bf16x8*)(qrow + 16 * ks + 8 * h);
#pragma unroll
    for (int d = 0; d < 4; ++d) O[d] = zero16();
    lsum = 0.f;
    const f32x16 minit = splat16(negM2);
    __syncthreads();
    __builtin_amdgcn_global_load_lds((const unsigned*)kgs, (lds_ptr_t)(lds + wb), 16, 0, 0);
    __builtin_amdgcn_global_load_lds((const unsigned*)vgs, (lds_ptr_t)(lds + 8192 + wb), 16, 0, 0);
    __builtin_amdgcn_global_load_lds((const unsigned*)(vgs + (size_t)64 * kS), (lds_ptr_t)(lds + 16384 + wb), 16, 0, 0);
    asm volatile("s_waitcnt vmcnt(0)" ::: "memory");
    __syncthreads();
    for (int kt = 0; kt < nkt; ++kt) {
        char* st = lds + (kt & 1) * 24576;
        if (kt + 1 < nkt) {
            char* st2 = lds + ((kt + 1) & 1) * 24576 + wb;
            __builtin_amdgcn_global_load_lds((const unsigned*)(kgs + (size_t)(kt + 1) * 64 * 512), (lds_ptr_t)(st2), 16, 0, 0);
            __builtin_amdgcn_global_load_lds((const unsigned*)(vgs + (kt + 1) * 64), (lds_ptr_t)(st2 + 8192), 16, 0, 0);
            __builtin_amdgcn_global_load_lds((const unsigned*)(vgs + (size_t)64 * kS + (kt + 1) * 64), (lds_ptr_t)(st2 + 16384), 16, 0, 0);
        }
        __builtin_amdgcn_sched_barrier(0);
        if (kt * 64 <= q0 + 31) {
            f32x16 Sx[2];
            {
                bf16x8 kf[2][4];
#pragma unroll
                for (int kb = 0; kb < 2; ++kb)
#pragma unroll
                    for (int ks = 0; ks < 4; ++ks) kf[kb][ks] = *(const bf16x8*)(st + (32 * kb + l31) * 128 + (((2 * ks + h) ^ f) << 4));
                __builtin_amdgcn_sched_barrier(0);
#pragma unroll
                for (int ks = 0; ks < 4; ++ks)
#pragma unroll
                    for (int kb = 0; kb < 2; ++kb) Sx[kb] = ks == 0 ? MFMA(kf[kb][0], qf[0], minit) : MFMA(kf[kb][ks], qf[ks], Sx[kb]);
            }
            if (kt * 64 + 63 > q0) {
#pragma unroll
                for (int kb = 0; kb < 2; ++kb)
#pragma unroll
                    for (int i = 0; i < 16; ++i) {
                        float p = fexp2(Sx[kb][i]);
                        const int key = kt * 64 + 32 * kb + (i & 3) + 8 * (i >> 2) + 4 * h;
                        if (key > qpos) p = 0.f;
                        lsum += p; Sx[kb][i] = p;
                    }
            } else {
                float l0 = 0.f, l1 = 0.f;
#pragma unroll
                for (int i = 0; i < 16; ++i) { const float p0 = fexp2(Sx[0][i]), p1 = fexp2(Sx[1][i]); l0 += p0; l1 += p1; Sx[0][i] = p0; Sx[1][i] = p1; }
                lsum += l0 + l1;
            }
            bf16x8 pf[4];
            pf[0] = pack8(Sx[0], 0); pf[1] = pack8(Sx[0], 1); pf[2] = pack8(Sx[1], 0); pf[3] = pack8(Sx[1], 1);
            {
                bf16x8 vf[2][4];
#pragma unroll
                for (int db = 0; db < 4; ++db) vf[0][db] = *(const bf16x8*)(st + 8192 + (32 * db + l31) * 128 + ((h ^ f) << 4));
#pragma unroll
                for (int s = 0; s < 4; ++s) {
                    if (s < 3) {
#pragma unroll
                        for (int db = 0; db < 4; ++db) vf[(s + 1) & 1][db] = *(const bf16x8*)(st + 8192 + (32 * db + l31) * 128 + (((2 * (s + 1) + h) ^ f) << 4));
                    }
#pragma unroll
                    for (int db = 0; db < 4; ++db) O[db] = MFMA(vf[s & 1][db], pf[s], O[db]);
                    __builtin_amdgcn_sched_barrier(0);
                }
            }
        }
        asm volatile("s_waitcnt vmcnt(0)" ::: "memory");
        __syncthreads();
    }
    lsum += __shfl_xor(lsum, 32);
}

DI void diff_item(const Params& P, int layer, int b, int hd, int qt, float lam, float omli, float negM2, char* lds) {
    const int t = tid(), lane = t & 63, w = t >> 6, h = lane >> 5, l31 = lane & 31;
    const int lr = t >> 3, lc = t & 7;
    bf16_t* dq = slotp(P, SL_DQ); const bf16_t* dk = slotp(P, SL_DK); const bf16_t* dvT = slotp(P, SL_DVT); const bf16_t* dz = slotp(P, SL_DZ);
    const int q0 = qt * 256 + 32 * w;
    const size_t tokq = (size_t)b * kS + q0 + l31;
    const int nkt = (qt + 1) * 4;
    const bf16_t* vg = dvT + ((size_t)(b * 4 + hd) * 128 + lr) * kS + lc * 8;
    u32x4* o0s = (u32x4*)(lds + 49152) + t;
    f32x16 O[4]; float lsum;
#pragma unroll 1
    for (int c = 0; c < 2; ++c) {
        const bf16_t* kg = dk + ((size_t)b * kS + lr) * 512 + hd * 128 + c * 64 + lc * 8;
        diff_pass(dq + tokq * 512 + hd * 128 + c * 64, kg, vg, nkt, q0, negM2, O, lsum, lds);
        if (c == 0) {
            const float inv = frcp(lsum);
#pragma unroll
            for (int db = 0; db < 4; ++db)
#pragma unroll
                for (int i = 0; i < 2; ++i) {
                    u32x4 pkd = {pk2(O[db][8 * i] * inv, O[db][8 * i + 1] * inv), pk2(O[db][8 * i + 2] * inv, O[db][8 * i + 3] * inv),
                                 pk2(O[db][8 * i + 4] * inv, O[db][8 * i + 5] * inv), pk2(O[db][8 * i + 6] * inv, O[db][8 * i + 7] * inv)};
                    o0s[(db * 2 + i) * 512] = pkd;
                }
        }
    }
    const float inv = frcp(lsum) * lam;
    float ss = 0.f;
#pragma unroll
    for (int db = 0; db < 4; ++db) {
#pragma unroll
        for (int i2 = 0; i2 < 2; ++i2) {
            const u32x4 pkd = o0s[(db * 2 + i2) * 512];
#pragma unroll
            for (int j = 0; j < 4; ++j) {
                const int i = 4 * i2 + j;
                const float a = bf_lo(pkd[j]) - O[db][2 * i] * inv, c = bf_hi(pkd[j]) - O[db][2 * i + 1] * inv;
                O[db][2 * i] = a; O[db][2 * i + 1] = c; ss += a * a + c * c;
            }
        }
        __builtin_amdgcn_sched_barrier(0);
    }
    ss += __shfl_xor(ss, 32);
    const float rs = __builtin_amdgcn_rsqf(ss * (1.f / 128.f) + kEps) * omli;
    const float* sw = P.subln + layer * 128;
#pragma unroll
    for (int db = 0; db < 4; ++db) {
#pragma unroll
        for (int q4 = 0; q4 < 4; ++q4) {
            const int dv = 32 * db + 8 * q4 + 4 * h;
            const f32x4 w4 = *(const f32x4*)(sw + dv);
            const u32x2 z2 = *(const u32x2*)(dz + tokq * 512 + hd * 128 + dv);
            const float r0 = O[db][4 * q4] * rs * w4[0] * bf_lo(z2[0]), r1 = O[db][4 * q4 + 1] * rs * w4[1] * bf_hi(z2[0]);
            const float r2 = O[db][4 * q4 + 2] * rs * w4[2] * bf_lo(z2[1]), r3 = O[db][4 * q4 + 3] * rs * w4[3] * bf_hi(z2[1]);
            u32x2 o = {pk2(r0, r1), pk2(r2, r3)};
            *(u32x2*)(dq + tokq * 512 + hd * 128 + dv) = o;
        }
        __builtin_amdgcn_sched_barrier(0);
    }
}

constexpr float kSbExit = -24.f * 1.4426950408889634f;

DI void sb_item(const Params& P, int b, int hd, int qt, char* lds) {
    const int t = tid(), lane = t & 63, w = t >> 6, h = lane >> 5, l31 = lane & 31, f = (lane >> 1) & 7;
    const int lr = t >> 3, lc = t & 7;
    const int wofs = lr * 128 + ((lc ^ ((lr >> 1) & 7)) << 4);
    bf16_t* sq = slotp(P, SL_SQ); const bf16_t* sk = slotp(P, SL_SK); const bf16_t* svT = slotp(P, SL_SVT); const bf16_t* sz = slotp(P, SL_SZ);
    const int q0 = qt * 256 + 32 * w, qpos = q0 + l31;
    const size_t tokq = (size_t)b * kS + qpos;
    volatile int* flags = (volatile int*)(lds + 32768);
    bf16x8 qf[4];
#pragma unroll
    for (int ks = 0; ks < 4; ++ks) qf[ks] = *(const bf16x8*)(sq + tokq * 512 + hd * 64 + 16 * ks + 8 * h);
    f32x16 O[2]; O[0] = zero16(); O[1] = zero16();
    float R = 0.f; bool done = false;
    const bf16_t* kg = sk + ((size_t)b * kS + lr) * 512 + hd * 64 + lc * 8;
    const bf16_t* vg = svT + ((size_t)(b * 8 + hd) * 64 + lr) * kS + lc * 8;
    const int ktop = qt * 4 + 3;
    const int scd = ((lc ^ ((lr >> 1) & 7)) - lc) * 8;
    const bf16_t* kgs = kg + scd; const bf16_t* vgs = vg + scd;
    const int wb = w * 1024;
    __builtin_amdgcn_global_load_lds((const unsigned*)(kgs + (size_t)ktop * 64 * 512), (lds_ptr_t)(lds + wb), 16, 0, 0);
    __builtin_amdgcn_global_load_lds((const unsigned*)(vgs + ktop * 64), (lds_ptr_t)(lds + 8192 + wb), 16, 0, 0);
    asm volatile("s_waitcnt vmcnt(0)" ::: "memory");
    __syncthreads();
    for (int kt = ktop, it = 0; kt >= 0; --kt, ++it) {
        char* st = lds + (it & 1) * 16384;
        const bool more = kt > 0;
        if (more) {
            char* st2 = lds + ((it + 1) & 1) * 16384 + wb;
            __builtin_amdgcn_global_load_lds((const unsigned*)(kgs + (size_t)(kt - 1) * 64 * 512), (lds_ptr_t)(st2), 16, 0, 0);
            __builtin_amdgcn_global_load_lds((const unsigned*)(vgs + (kt - 1) * 64), (lds_ptr_t)(st2 + 8192), 16, 0, 0);
        }
        __builtin_amdgcn_sched_barrier(0);
        if (!done && kt * 64 < q0 + 31) {
            f32x16 Z[2];
#pragma unroll
            for (int kb = 0; kb < 2; ++kb) {
                Z[kb] = zero16();
#pragma unroll
                for (int ks = 0; ks < 4; ++ks) {
                    const bf16x8 kf = *(const bf16x8*)(st + (32 * kb + l31) * 128 + (((2 * ks + h) ^ f) << 4));
                    Z[kb] = MFMA(kf, qf[ks], Z[kb]);
                }
            }
            const bool diag = kt * 64 + 63 >= q0;
            float run = R;
#pragma unroll
            for (int kb = 1; kb >= 0; --kb) {
                float Lv[16];
                if (diag) {
#pragma unroll
                    for (int i = 0; i < 16; ++i) {
                        const float z = Z[kb][i];
                        const float sp = fmaxf(z, 0.f) + flog2(1.f + fexp2(-fabsf(z)));
                        const int key = kt * 64 + 32 * kb + (i & 3) + 8 * (i >> 2) + 4 * h;
                        const bool past = key < qpos;
                        Lv[i] = past ? -sp : 0.f;
                        Z[kb][i] = past ? z : -1e30f;
                    }
                } else {
#pragma unroll
                    for (int i = 0; i < 16; ++i) {
                        const float z = Z[kb][i];
                        Lv[i] = -(fmaxf(z, 0.f) + flog2(1.f + fexp2(-fabsf(z))));
                    }
                }
                float cs[4], ps[4];
#pragma unroll
                for (int g = 0; g < 4; ++g) { cs[g] = (Lv[4 * g] + Lv[4 * g + 1]) + (Lv[4 * g + 2] + Lv[4 * g + 3]); ps[g] = __shfl_xor(cs[g], 32); }
#pragma unroll
                for (int g = 3; g >= 0; --g) {
                    const float off = run + (h == 0 ? ps[g] : 0.f);
                    const float l3 = off, l2 = l3 + Lv[4 * g + 3], l1 = l2 + Lv[4 * g + 2], l0 = l1 + Lv[4 * g + 1];
                    Z[kb][4 * g + 3] = fexp2(Z[kb][4 * g + 3] + Lv[4 * g + 3] + l3);
                    Z[kb][4 * g + 2] = fexp2(Z[kb][4 * g + 2] + Lv[4 * g + 2] + l2);
                    Z[kb][4 * g + 1] = fexp2(Z[kb][4 * g + 1] + Lv[4 * g + 1] + l1);
                    Z[kb][4 * g + 0] = fexp2(Z[kb][4 * g + 0] + Lv[4 * g + 0] + l0);
                    run += cs[g] + ps[g];
                }
            }
            R = run;
            bf16x8 pf[4];
            pf[0] = pack8(Z[0], 0); pf[1] = pack8(Z[0], 1); pf[2] = pack8(Z[1], 0); pf[3] = pack8(Z[1], 1);
#pragma unroll
            for (int s = 0; s < 4; ++s)
#pragma unroll
                for (int db = 0; db < 2; ++db) {
                    const bf16x8 vf = *(const bf16x8*)(st + 8192 + (32 * db + l31) * 128 + (((2 * s + h) ^ f) << 4));
                    O[db] = MFMA(vf, pf[s], O[db]);
                }
            done = __all(R < kSbExit) != 0;
        }
        if (lane == 0) flags[(it & 1) * 8 + w] = done ? 1 : 0;
        asm volatile("s_waitcnt vmcnt(0)" ::: "memory");
        __syncthreads();
        int alld = 1;
#pragma unroll
        for (int i = 0; i < 8; ++i) alld &= flags[(it & 1) * 8 + i];
        if (alld) break;
    }
#pragma unroll
    for (int db = 0; db < 2; ++db)
#pragma unroll
        for (int q4 = 0; q4 < 4; ++q4) {
            const int dv = 32 * db + 8 * q4 + 4 * h;
            const u32x2 z2 = *(const u32x2*)(sz + tokq * 512 + hd * 64 + dv);
            u32x2 o = {pk2(O[db][4 * q4] * bf_lo(z2[0]), O[db][4 * q4 + 1] * bf_hi(z2[0])), pk2(O[db][4 * q4 + 2] * bf_lo(z2[1]), O[db][4 * q4 + 3] * bf_hi(z2[1]))};
            *(u32x2*)(sq + tokq * 512 + hd * 64 + dv) = o;
        }
    __syncthreads();
}

DI void attn_phase(const Params& P, int layer, char* lds) {
    conv_pass(P, layer);
    const int lane = tid() & 63;
    float a1 = P.lq1[layer * 64 + lane] * P.lk1[layer * 64 + lane], a2 = P.lq2[layer * 64 + lane] * P.lk2[layer * 64 + lane];
    float mq = fabsf(P.dqn[layer * 64 + lane]), mk = fabsf(P.dkn[layer * 64 + lane]);
#pragma unroll
    for (int o = 32; o >= 1; o >>= 1) { a1 += __shfl_xor(a1, o); a2 += __shfl_xor(a2, o); mq = fmaxf(mq, __shfl_xor(mq, o)); mk = fmaxf(mk, __shfl_xor(mk, o)); }
    const float lam_init = 0.8f - 0.6f * __expf(-0.3f * (float)layer);
    const float lam = __expf(a1) - __expf(a2) + lam_init;
    const float negM2 = -(8.f * mq * mk * kLog2e);
    for (int i = blockIdx.x; i < 256; i += gridDim.x) {
        const int x = i & 7, j = i >> 3, bh = x * 2 + (j >> 4), pr = j & 15;
#pragma unroll 1
        for (int e = 0; e < 2; ++e) diff_item(P, layer, bh >> 2, bh & 3, e ? pr : 31 - pr, lam, 1.f - lam_init, negM2, lds);
    }
    for (int i = blockIdx.x; i < 1024; i += gridDim.x) {
        const int x = i & 7, j = i >> 3, bh = x * 4 + (j >> 5), qt = j & 31;
        sb_item(P, bh >> 3, bh & 7, qt, lds);
    }
}

DI unsigned q8(float g) { return (unsigned)(g * 255.f + 0.5f); }
DI unsigned q8x4(float a, float b, float c, float d) { return q8(a) | (q8(b) << 8) | (q8(c) << 16) | (q8(d) << 24); }
DI float dq8(unsigned w, int k) { return (float)((w >> (8 * k)) & 255u) * (1.f / 255.f); }
DI u32x4* gate_slot(const Params& P, int tile, int j, int g8) { return (u32x4*)slotp(P, SL_SK) + ((size_t)(tile * 3 + j) * 8 + g8) * 512 + tid(); }

DI void gate_epilogue(const Params& P, int layer, int j, const f32x4 (&acc)[2][2][4][2], int tile, int n0, const char* lds) {
    LANE_DECODE; (void)lane;
    const float* rsl = (const float*)(lds + LDS_RS);
#pragma unroll
    for (int ai = 0; ai < 2; ++ai) {
        const int col = n0 + ai * 128 + wr * 64 + 8 * fq;
        const float* bg = P.b_gate + layer * 3072 + j * 1024 + col;
        const f32x4 b0 = *(const f32x4*)bg, b1 = *(const f32x4*)(bg + 4), b2 = *(const f32x4*)(bg + 32), b3 = *(const f32x4*)(bg + 36);
#pragma unroll
        for (int bj = 0; bj < 2; ++bj)
#pragma unroll
            for (int nn = 0; nn < 2; ++nn) {
                const int rl = bj * 128 + wc * 32 + nn * 16 + fr;
                float lo[8], hi[8];
                grp16(acc, ai, bj, nn, rsl[rl], lo, hi);
#pragma unroll
                for (int i = 0; i < 4; ++i) { lo[i] = sigm(lo[i] + b0[i]); lo[4 + i] = sigm(lo[4 + i] + b1[i]); hi[i] = sigm(hi[i] + b2[i]); hi[4 + i] = sigm(hi[4 + i] + b3[i]); }
                u32x4 o = {q8x4(lo[0], lo[1], lo[2], lo[3]), q8x4(lo[4], lo[5], lo[6], lo[7]), q8x4(hi[0], hi[1], hi[2], hi[3]), q8x4(hi[4], hi[5], hi[6], hi[7])};
                *gate_slot(P, tile, j, ai * 4 + bj * 2 + nn) = o;
                __builtin_amdgcn_sched_barrier(0);
            }
    }
}

DI void y_epilogue(const Params& P, int j, bf16_t* __restrict__ hb, const f32x4 (&acc)[2][2][4][2], int tile, int m0, int n0) {
    LANE_DECODE; (void)lane;
#pragma unroll
    for (int ai = 0; ai < 2; ++ai)
#pragma unroll
        for (int bj = 0; bj < 2; ++bj)
#pragma unroll
            for (int nn = 0; nn < 2; ++nn) {
                const size_t tok = (size_t)m0 + bj * 128 + wc * 32 + nn * 16 + fr;
                const int col = n0 + ai * 128 + wr * 64 + 8 * fq;
                float lo[8], hi[8];
                grp16(acc, ai, bj, nn, 1.f, lo, hi);
                const u32x4 gq = *gate_slot(P, tile, j, ai * 4 + bj * 2 + nn);
                bf16_t* hp = hb + tok * 1024 + col;
                u32x4 h0 = {0u, 0u, 0u, 0u}, h1 = {0u, 0u, 0u, 0u};
                if (j > 0) { h0 = *(const u32x4*)hp; h1 = *(const u32x4*)(hp + 32); }
                u32x4 o0, o1;
#pragma unroll
                for (int i = 0; i < 4; ++i) {
                    o0[i] = pk2(bf_lo(h0[i]) + dq8(gq[i >> 1], 2 * (i & 1)) * lo[2 * i], bf_hi(h0[i]) + dq8(gq[i >> 1], 2 * (i & 1) + 1) * lo[2 * i + 1]);
                    o1[i] = pk2(bf_lo(h1[i]) + dq8(gq[2 + (i >> 1)], 2 * (i & 1)) * hi[2 * i], bf_hi(h1[i]) + dq8(gq[2 + (i >> 1)], 2 * (i & 1) + 1) * hi[2 * i + 1]);
                }
                *(u32x4*)hp = o0; *(u32x4*)(hp + 32) = o1;
                __builtin_amdgcn_sched_barrier(0);
            }
}

DI void merge_phase(const Params& P, int layer, char* lds) {
    const bf16_t* xb = (const bf16_t*)(P.ws + ((layer & 1) ? OFF_HB : OFF_XN));
    bf16_t* hb = (bf16_t*)(P.ws + ((layer & 1) ? OFF_XN : OFF_HB));
    const float* ssq = (const float*)(P.ws + OFF_SSQA);
    for (int t = blockIdx.x; t < 128 * 4; t += gridDim.x) {
        int mt, nt; tile_map(t, mt, nt);
        const int m0 = mt * 256, n0 = nt * 256;
        tile_rstd(ssq, m0, lds);
#pragma unroll 1
        for (int j = 0; j < 3; ++j) {
            f32x4 acc[2][2][4][2];
            gemm8(acc, wtp(P, layer, W_G) + (size_t)(j * 1024 + n0) * 1024, xb + (size_t)m0 * 1024, 1024, lds);
            gate_epilogue(P, layer, j, acc, t, n0, lds);
            const bf16_t* Aj = slotp(P, j == 0 ? SL_BZ : (j == 1 ? SL_SQ : SL_DQ));
            const bf16_t* Wj = wtp(P, layer, j == 0 ? W_OC : (j == 1 ? W_OSB : W_OD));
            gemm8(acc, Wj + (size_t)n0 * 512, Aj + (size_t)m0 * 512, 512, lds);
            y_epilogue(P, j, hb, acc, t, m0, n0);
        }
    }
    p_to_bf16(P.p + (size_t)layer * kT * 256, slotp(P, SL_CU));
}

template <bool XBF, bool WF32>
DI void resid_epilogue(const float* __restrict__ xs, const bf16_t* __restrict__ xsb, float* __restrict__ out, bf16_t* __restrict__ xbn, float* __restrict__ ssq,
                       const f32x4 (&acc)[2][2][4][2], int m0, int n0, int nt, bool wxb = true) {
    LANE_DECODE; (void)lane;
#pragma unroll
    for (int bj = 0; bj < 2; ++bj)
#pragma unroll
        for (int nn = 0; nn < 2; ++nn) {
            const size_t tok = (size_t)m0 + bj * 128 + wc * 32 + nn * 16 + fr;
            float ss = 0.f;
#pragma unroll
            for (int ai = 0; ai < 2; ++ai) {
                float lo[8], hi[8];
                grp16(acc, ai, bj, nn, 1.f, lo, hi);
                const size_t o = tok * 1024 + n0 + ai * 128 + wr * 64 + 8 * fq;
                if (XBF) {
                    const u32x4 xl = *(const u32x4*)(xsb + o), xh = *(const u32x4*)(xsb + o + 32);
#pragma unroll
                    for (int j = 0; j < 4; ++j) { lo[2 * j] += bf_lo(xl[j]); lo[2 * j + 1] += bf_hi(xl[j]); hi[2 * j] += bf_lo(xh[j]); hi[2 * j + 1] += bf_hi(xh[j]); }
                } else {
#pragma unroll
                    for (int q4 = 0; q4 < 2; ++q4) {
                        const f32x4 xl = *(const f32x4*)(xs + o + 4 * q4), xh = *(const f32x4*)(xs + o + 32 + 4 * q4);
#pragma unroll
                        for (int j = 0; j < 4; ++j) { lo[4 * q4 + j] += xl[j]; hi[4 * q4 + j] += xh[j]; }
                    }
                }
#pragma unroll
                for (int i = 0; i < 8; ++i) ss += lo[i] * lo[i] + hi[i] * hi[i];
                if (WF32) {
#pragma unroll
                    for (int q4 = 0; q4 < 2; ++q4) {
                        *(f32x4*)(out + o + 4 * q4) = (f32x4){lo[4 * q4], lo[4 * q4 + 1], lo[4 * q4 + 2], lo[4 * q4 + 3]};
                        *(f32x4*)(out + o + 32 + 4 * q4) = (f32x4){hi[4 * q4], hi[4 * q4 + 1], hi[4 * q4 + 2], hi[4 * q4 + 3]};
                    }
                }
                if (wxb) { st8(xbn + o, lo); st8(xbn + o + 32, hi); }
            }
            ss += __shfl_xor(ss, 16); ss += __shfl_xor(ss, 32);
            if (wxb && fq < 2) ssq[tok * 16 + 4 * nt + 2 * fq + wr] = fq == 0 ? ss : 0.f;
            __builtin_amdgcn_sched_barrier(0);
        }
}

DI void wout_phase(const Params& P, int layer, char* lds) {
    const bf16_t* hb = (const bf16_t*)(P.ws + ((layer & 1) ? OFF_XN : OFF_HB));
    bf16_t* xb2 = (bf16_t*)(P.ws + ((layer & 1) ? OFF_HB : OFF_XN));
    const float* xs = layer == 0 ? P.x : P.out;
    for (int t = blockIdx.x; t < 128 * 4; t += gridDim.x) {
        int mt, nt; tile_map(t, mt, nt);
        const int m0 = mt * 256, n0 = nt * 256;
        f32x4 acc[2][2][4][2];
        gemm8(acc, wtp(P, layer, W_OUT) + (size_t)n0 * 1024, hb + (size_t)m0 * 1024, 1024, lds);
        resid_epilogue<false, false>(xs, nullptr, nullptr, xb2, (float*)(P.ws + OFF_SSQB), acc, m0, n0, nt);
    }
}

DI u32x4* ple_slot(const Params& P, int tile, int g8) { return (u32x4*)slotp(P, SL_SQ) + ((size_t)tile * 8 + g8) * 512 + tid(); }

DI void ple_gate_store(const Params& P, const f32x4 (&acc)[2][2][4][2], int tile, const char* lds) {
    LANE_DECODE; (void)lane; (void)wr; (void)fq;
    const float* rsl = (const float*)(lds + LDS_RS);
#pragma unroll
    for (int ai = 0; ai < 2; ++ai)
#pragma unroll
        for (int bj = 0; bj < 2; ++bj)
#pragma unroll
            for (int nn = 0; nn < 2; ++nn) {
                float lo[8], hi[8];
                grp16(acc, ai, bj, nn, rsl[bj * 128 + wc * 32 + nn * 16 + fr], lo, hi);
#pragma unroll
                for (int i = 0; i < 8; ++i) { lo[i] = sigm(lo[i]); hi[i] = sigm(hi[i]); }
                u32x4 o = {q8x4(lo[0], lo[1], lo[2], lo[3]), q8x4(lo[4], lo[5], lo[6], lo[7]), q8x4(hi[0], hi[1], hi[2], hi[3]), q8x4(hi[4], hi[5], hi[6], hi[7])};
                *ple_slot(P, tile, ai * 4 + bj * 2 + nn) = o;
                __builtin_amdgcn_sched_barrier(0);
            }
}

DI void ple_gate_apply(const Params& P, f32x4 (&acc)[2][2][4][2], int tile) {
#pragma unroll
    for (int ai = 0; ai < 2; ++ai)
#pragma unroll
        for (int bj = 0; bj < 2; ++bj)
#pragma unroll
            for (int nn = 0; nn < 2; ++nn) {
                const u32x4 gq = *ple_slot(P, tile, ai * 4 + bj * 2 + nn);
#pragma unroll
                for (int e = 0; e < 8; ++e) {
                    acc[ai][bj][e >> 2][nn][e & 3] *= dq8(gq[e >> 2], e & 3);
                    acc[ai][bj][2 + (e >> 2)][nn][e & 3] *= dq8(gq[2 + (e >> 2)], e & 3);
                }
                __builtin_amdgcn_sched_barrier(0);
            }
}

DI void ple_phase(const Params& P, int layer, char* lds) {
    const bf16_t* xb2 = (const bf16_t*)(P.ws + ((layer & 1) ? OFF_HB : OFF_XN));
    bf16_t* xb3 = (bf16_t*)(P.ws + ((layer & 1) ? OFF_XN : OFF_HB));
    const bf16_t* pb = slotp(P, SL_CU);
    for (int t = blockIdx.x; t < 128 * 4; t += gridDim.x) {
        int mt, nt; tile_map(t, mt, nt);
        const int m0 = mt * 256, n0 = nt * 256;
        tile_rstd((const float*)(P.ws + OFF_SSQB), m0, lds);
        f32x4 acc[2][2][4][2];
        gemm8(acc, wtp(P, layer, W_PG) + (size_t)n0 * 1024, xb2 + (size_t)m0 * 1024, 1024, lds);
        ple_gate_store(P, acc, t, lds);
        gemm8(acc, wtp(P, layer, W_PLE) + (size_t)n0 * 256, pb + (size_t)m0 * 256, 256, lds);
        ple_gate_apply(P, acc, t);
        resid_epilogue<true, true>(nullptr, xb2, P.out, xb3, (float*)(P.ws + OFF_SSQA), acc, m0, n0, nt, layer == 0);
    }
}

DI void prologue_phase(const Params& P, char* lds) {
    for (int l = 0; l < 2; ++l) {
        convert_job(P.w_in + (size_t)l * 1024 * 9216, 9216, 1024, 6144, 1, 0, P.norm_w + l * 1024, wtp(P, l, W_IN), lds);
        convert_job(P.w_in + (size_t)l * 1024 * 9216, 9216, 1024, 3072, 0, 6144, P.norm_w + l * 1024, wtp(P, l, W_G), lds);
        convert_job(P.w_oc + (size_t)l * 512 * 1024, 1024, 512, 1024, 0, 0, nullptr, wtp(P, l, W_OC), lds);
        convert_job(P.w_osb + (size_t)l * 512 * 1024, 1024, 512, 1024, 0, 0, nullptr, wtp(P, l, W_OSB), lds);
        convert_job(P.w_od + (size_t)l * 512 * 1024, 1024, 512, 1024, 0, 0, nullptr, wtp(P, l, W_OD), lds);
        convert_job(P.w_out + (size_t)l * 1024 * 1024, 1024, 1024, 1024, 0, 0, nullptr, wtp(P, l, W_OUT), lds);
        convert_job(P.w_pg + (size_t)l * 1024 * 1024, 1024, 1024, 1024, 0, 0, P.ple_norm + l * 1024, wtp(P, l, W_PG), lds);
        convert_job(P.w_ple + (size_t)l * 256 * 1024, 1024, 256, 1024, 0, 0, nullptr, wtp(P, l, W_PLE), lds);
    }
    rope_tables(P);
    x_to_bf16_ssq(P.x, (bf16_t*)(P.ws + OFF_XN), (float*)(P.ws + OFF_SSQA));
}

constexpr int kNumPhases = 11;
DI void run_phase(const Params& P, int ph, char* lds) {
    if (ph == 0) { prologue_phase(P, lds); return; }
    const int layer = (ph - 1) / 5, s = (ph - 1) % 5;
    switch (s) {
        case 0: inproj_phase(P, layer, lds); break;
        case 1: attn_phase(P, layer, lds); break;
        case 2: merge_phase(P, layer, lds); break;
        case 3: wout_phase(P, layer, lds); break;
        default: ple_phase(P, layer, lds); break;
    }
}


#define XB_TMO      128
#define XB_XCNT(j)  (256  + 64 * (j))
#define XB_XSUB(j)  (1280 + 64 * (j))
#define XB_XGEN(j)  (2304 + 64 * (j))
#define XB_TOP      3328
#define XB_TOPGEN   3392
#define XCD_BAR_WORDS 3456
#define XB_SPIN_CAP (1u << 22)
#define LAS __attribute__((address_space(3)))
DI unsigned xb_ld(unsigned* p) { return __hip_atomic_load(p, __ATOMIC_RELAXED, __HIP_MEMORY_SCOPE_AGENT); }
DI unsigned xb_add(unsigned* p, unsigned v) { return __hip_atomic_fetch_add(p, v, __ATOMIC_RELAXED, __HIP_MEMORY_SCOPE_AGENT); }
DI unsigned xb_xcc_id() { return (unsigned)__builtin_amdgcn_s_getreg((3 << 11) | 20) & 0xFu; }
#define XB_SPIN(cond, bar) do { unsigned _sp = 0; while (cond) { __builtin_amdgcn_s_sleep(1); \
    if ((++_sp & 255u) == 0u) { if (xb_ld(&(bar)[XB_TMO])) break; if (_sp > XB_SPIN_CAP) { atomicAdd(&(bar)[XB_TMO], 1u); break; } } } } while (0)
struct XcdBarrier { unsigned* bar; unsigned x; volatile LAS unsigned* st; };
DI XcdBarrier xcd_barrier_post(unsigned* bar, volatile LAS unsigned* st) {
    XcdBarrier b; b.bar = bar; b.x = xb_xcc_id(); b.st = st;
    if (threadIdx.x == 0) (void)xb_add(&bar[XB_XCNT(b.x)], 1u);
    return b;
}
DI void xcd_barrier_complete(unsigned* bar, unsigned x, unsigned& nloc, unsigned& nx) {
    const unsigned G = gridDim.x * gridDim.y * gridDim.z;
    unsigned sum, cnt, mine, sp = 0u;
    for (;;) {
        sum = 0u; cnt = 0u; mine = 0u;
#pragma unroll
        for (unsigned j = 0; j < 16; ++j) { const unsigned c = xb_ld(&bar[XB_XCNT(j)]); sum += c; cnt += (c > 0u) ? 1u : 0u; mine = (j == x) ? c : mine; }
        if (sum == G) break;
        __builtin_amdgcn_s_sleep(1);
        if ((++sp & 255u) == 0u) { if (xb_ld(&bar[XB_TMO])) break; if (sp > XB_SPIN_CAP) { atomicAdd(&bar[XB_TMO], 1u); break; } }
    }
    nloc = mine > 0u ? mine : 1u; nx = cnt > 0u ? cnt : 1u;
}
DI void xcd_barrier(const XcdBarrier& b) {
    asm volatile("s_waitcnt vmcnt(0)" ::: "memory");
    __syncthreads();
    if (threadIdx.x == 0) {
        unsigned* bar = b.bar;
        __builtin_amdgcn_s_waitcnt(0);
        unsigned nloc = b.st[0], nx = b.st[1];
        if (nloc == 0u) { xcd_barrier_complete(bar, b.x, nloc, nx); b.st[0] = nloc; b.st[1] = nx; }
        const unsigned old = xb_add(&bar[XB_XSUB(b.x)], 1u);
        const unsigned gen = old / nloc;
        if (old + 1u == (gen + 1u) * nloc) {
            __builtin_amdgcn_fence(__ATOMIC_RELEASE, "agent");
            asm volatile("s_waitcnt vmcnt(0)" ::: "memory");
            const unsigned og = xb_add(&bar[XB_TOP], 1u);
            const unsigned tg = og / nx;
            if (og + 1u == (tg + 1u) * nx) xb_add(&bar[XB_TOPGEN], 1u);
            else XB_SPIN(xb_ld(&bar[XB_TOPGEN]) == tg, bar);
            __builtin_amdgcn_fence(__ATOMIC_ACQUIRE, "agent");
            xb_add(&bar[XB_XGEN(b.x)], 1u);
            asm volatile("s_waitcnt vmcnt(0)" ::: "memory");
        } else {
            XB_SPIN(xb_ld(&bar[XB_XGEN(b.x)]) == gen, bar);
            __builtin_amdgcn_fence(__ATOMIC_ACQUIRE, "agent");
            asm volatile("s_waitcnt vmcnt(0)" ::: "memory");
        }
    }
    __syncthreads();
}

__global__ void __launch_bounds__(512) fwd_megakernel(Params P) {
    __shared__ __attribute__((aligned(16))) char smem[LDS_BYTES];
    unsigned* bar = (unsigned*)(P.ws + OFF_BAR);
    volatile LAS unsigned* xst = (volatile LAS unsigned*)(smem + LDS_XB);
    if (threadIdx.x < 4) xst[threadIdx.x] = 0u;
    if (blockIdx.x == 0) for (int i = threadIdx.x; i < XCD_BAR_WORDS; i += 512) bar[i] = 0u;
    __syncthreads();
    for (int ph = P.ph_lo; ph < P.ph_hi; ++ph) {
        run_phase(P, ph, smem);
        if (ph + 1 < P.ph_hi) {
            if (ph == P.ph_lo) { cg::this_grid().sync(); (void)xcd_barrier_post((unsigned*)(P.ws + OFF_BAR), (volatile LAS unsigned*)(smem + LDS_XB)); }
            else { XcdBarrier xb; xb.bar = (unsigned*)(P.ws + OFF_BAR); xb.x = xb_xcc_id(); xb.st = (volatile LAS unsigned*)(smem + LDS_XB); xcd_barrier(xb); }
        }
    }
}

extern "C" void kernel_launch(void* const* d_in, const int* in_sizes, int n_in, void* d_out, int out_size, void* d_ws, size_t ws_size,
                              hipStream_t stream) {
    if (ws_size < WS_NEED) { fprintf(stderr, "workspace too small: %zu < %zu\n", ws_size, (size_t)WS_NEED); return; }
    Params P{};
    P.x = (const float*)d_in[0]; P.p = (const float*)d_in[1]; P.norm_w = (const float*)d_in[2]; P.w_in = (const float*)d_in[3];
    P.b_gate = (const float*)d_in[4]; P.conv_w = (const float*)d_in[5]; P.dqn = (const float*)d_in[6]; P.dkn = (const float*)d_in[7];
    P.lq1 = (const float*)d_in[8]; P.lk1 = (const float*)d_in[9]; P.lq2 = (const float*)d_in[10]; P.lk2 = (const float*)d_in[11];
    P.subln = (const float*)d_in[12]; P.w_oc = (const float*)d_in[13]; P.w_osb = (const float*)d_in[14]; P.w_od = (const float*)d_in[15];
    P.w_out = (const float*)d_in[16]; P.ple_norm = (const float*)d_in[17]; P.w_pg = (const float*)d_in[18]; P.w_ple = (const float*)d_in[19];
    P.out = (float*)d_out; P.ws = (char*)d_ws;
#if MK_MULTI
    for (int ph = 0; ph < kNumPhases; ++ph) {
        P.ph_lo = ph; P.ph_hi = ph + 1;
        hipLaunchKernelGGL(fwd_megakernel, dim3(256), dim3(512), 0, stream, P);
    }
#else
    static int grid_blocks = 0;
    if (!grid_blocks) {
        int dev = 0, cus = 0, per_cu = 0;
        (void)hipGetDevice(&dev);
        (void)hipDeviceGetAttribute(&cus, hipDeviceAttributeMultiprocessorCount, dev);
        (void)hipOccupancyMaxActiveBlocksPerMultiprocessor(&per_cu, fwd_megakernel, 512, 0);
        if (per_cu < 1) per_cu = 1;
        if (per_cu > 1) per_cu = 1;
        grid_blocks = cus * per_cu;
    }
    P.ph_lo = 0; P.ph_hi = kNumPhases;
    void* args[] = {&P};
    hipError_t e = hipLaunchCooperativeKernel((void*)fwd_megakernel, dim3(grid_blocks), dim3(512), args, 0, stream);
    if (e != hipSuccess) fprintf(stderr, "cooperative launch failed: %s (grid %d)\n", hipGetErrorString(e), grid_blocks);
#endif
}
```
